# Optimizing an MI355X kernel written in HIP

```python
import math
import jax, jax.numpy as jnp
from jax import lax
import numpy as np

D_MODEL = 1024
BATCH = 16
SEQ = 2048
DEPTH = 1

HEAD_DIM = 64
SWA_Q_HEADS = 8
SWA_KV_HEADS = 2
SB_HEADS = 8
WINDOW = 128
BLOCK = 128
ROPE_THETA = 10000.0
EPS = 1e-6
SWA_WIDTH = SWA_Q_HEADS * HEAD_DIM
SWA_KV_WIDTH = SWA_KV_HEADS * HEAD_DIM
SB_WIDTH = SB_HEADS * HEAD_DIM
MIX_WIDTH = SWA_WIDTH + SB_WIDTH
SPLITS = (SWA_WIDTH, SWA_KV_WIDTH, SWA_KV_WIDTH, SWA_WIDTH, SB_WIDTH, SB_WIDTH, SB_WIDTH, SB_WIDTH)
IN_WIDTH = sum(SPLITS)

kernel_name = "hybrid_swa_sink_stickbreaking_heads"


def rmsnorm(x, g):
    xf = x.astype(jnp.float32)
    y = xf * lax.rsqrt(jnp.mean(xf * xf, axis=-1, keepdims=True) + EPS)
    return (y * g.astype(jnp.float32)).astype(x.dtype)


def rope(x, positions):
    half = x.shape[-1] // 2
    inv_freq = ROPE_THETA ** (-jnp.arange(half, dtype=jnp.float32) * 2.0 / x.shape[-1])
    ang = positions.astype(jnp.float32)[..., None] * inv_freq
    cos = jnp.cos(ang)[:, :, None, :]
    sin = jnp.sin(ang)[:, :, None, :]
    xf = x.astype(jnp.float32)
    x1, x2 = xf[..., :half], xf[..., half:]
    out = jnp.concatenate([x1 * cos - x2 * sin, x2 * cos + x1 * sin], axis=-1)
    return out.astype(x.dtype)


def swa_sink_attention(q, k, v, sinks):
    B, S, Hq, d = q.shape
    Hkv = k.shape[2]
    G = Hq // Hkv
    nb = S // BLOCK
    scale = 1.0 / math.sqrt(d)
    qb = q.reshape(B, nb, BLOCK, Hkv, G, d)
    kb = k.reshape(B, nb, BLOCK, Hkv, d)
    vb = v.reshape(B, nb, BLOCK, Hkv, d)
    kprev = jnp.concatenate([jnp.zeros_like(kb[:, :1]), kb[:, :-1]], axis=1)
    vprev = jnp.concatenate([jnp.zeros_like(vb[:, :1]), vb[:, :-1]], axis=1)
    kw = jnp.concatenate([kprev, kb], axis=2)
    vw = jnp.concatenate([vprev, vb], axis=2)
    scores = jnp.einsum('bnqhgd,bnkhd->bnhgqk', qb, kw).astype(jnp.float32) * scale
    q_idx = jnp.arange(nb)[:, None] * BLOCK + jnp.arange(BLOCK)[None, :]
    k_idx = jnp.arange(nb)[:, None] * BLOCK - BLOCK + jnp.arange(2 * BLOCK)[None, :]
    diff = q_idx[:, :, None] - k_idx[:, None, :]
    mask = (diff >= 0) & (diff < WINDOW) & (k_idx[:, None, :] >= 0)
    scores = jnp.where(mask[None, :, None, None], scores, -jnp.inf)
    sink = sinks.astype(jnp.float32).reshape(Hkv, G)[None, None, :, :, None, None]
    m = jnp.maximum(jnp.max(scores, axis=-1, keepdims=True), sink)
    p = jnp.exp(scores - m)
    probs = p / (jnp.sum(p, axis=-1, keepdims=True) + jnp.exp(sink - m))
    out = jnp.einsum('bnhgqk,bnkhd->bnqhgd', probs.astype(v.dtype), vw)
    return out.reshape(B, S, Hq * d)


def stick_breaking_attention(q, k, v):
    B, S, H, d = q.shape
    nb = S // BLOCK
    scale = 1.0 / math.sqrt(d)
    outs = []
    for i in range(nb):
        t0 = i * BLOCK
        L = t0 + BLOCK
        qi = q[:, t0:L]
        kp = k[:, :L]
        vp = v[:, :L]
        z = jnp.einsum('bqhd,bkhd->bhqk', qi, kp).astype(jnp.float32) * scale
        t_idx = t0 + jnp.arange(BLOCK)[:, None]
        s_idx = jnp.arange(L)[None, :]
        causal = s_idx < t_idx
        log_fail = jnp.where(causal, jax.nn.log_sigmoid(-z), 0.0)
        after = lax.cumsum(log_fail, axis=3, reverse=True) - log_fail
        w = jnp.where(causal, jnp.exp(jax.nn.log_sigmoid(z) + after), 0.0)
        outs.append(jnp.einsum('bhqk,bkhd->bqhd', w.astype(v.dtype), vp))
    out = jnp.concatenate(outs, axis=1)
    return out.reshape(B, S, H * d)


def setup_inputs(seed: int = 0) -> dict:
    key = jax.random.key(seed)
    ks = jax.random.split(key, 8)
    x = jax.random.normal(ks[0], (BATCH, SEQ, D_MODEL), jnp.float32)
    positions = jnp.broadcast_to(jnp.arange(SEQ, dtype=jnp.int32)[None, :], (BATCH, SEQ)).astype(jnp.int32)
    norm_gain = 1.0 + 0.02 * jax.random.normal(ks[1], (DEPTH, D_MODEL), jnp.float32)
    w_in = jax.random.normal(ks[2], (DEPTH, D_MODEL, IN_WIDTH), jnp.float32) * D_MODEL ** -0.5
    q_norm_gain = 1.0 + 0.02 * jax.random.normal(ks[3], (DEPTH, HEAD_DIM), jnp.float32)
    k_norm_gain = 1.0 + 0.02 * jax.random.normal(ks[4], (DEPTH, HEAD_DIM), jnp.float32)
    sinks = 0.5 * jax.random.normal(ks[5], (DEPTH, SWA_Q_HEADS), jnp.float32)
    w_out = jax.random.normal(ks[6], (DEPTH, MIX_WIDTH, D_MODEL), jnp.float32) * MIX_WIDTH ** -0.5
    return {"x": x, "positions": positions, "norm_gain": norm_gain, "w_in": w_in,
            "q_norm_gain": q_norm_gain, "k_norm_gain": k_norm_gain, "sinks": sinks, "w_out": w_out}


def reference(x, positions, norm_gain, w_in, q_norm_gain, k_norm_gain, sinks, w_out):
    B, S, _ = x.shape
    split_points = list(np.cumsum(SPLITS)[:-1])
    for l in range(DEPTH):
        h = rmsnorm(x, norm_gain[l])
        proj = jnp.einsum('bsd,de->bse', h, w_in[l])
        qa, ka, va, ga, qb, kb, vb, gb = jnp.split(proj, split_points, axis=-1)
        qa = rope(rmsnorm(qa.reshape(B, S, SWA_Q_HEADS, HEAD_DIM), q_norm_gain[l]), positions)
        ka = rope(rmsnorm(ka.reshape(B, S, SWA_KV_HEADS, HEAD_DIM), k_norm_gain[l]), positions)
        va = va.reshape(B, S, SWA_KV_HEADS, HEAD_DIM)
        ya = swa_sink_attention(qa, ka, va, sinks[l]) * jax.nn.silu(ga)
        qb = qb.reshape(B, S, SB_HEADS, HEAD_DIM)
        kb = kb.reshape(B, S, SB_HEADS, HEAD_DIM)
        vb = vb.reshape(B, S, SB_HEADS, HEAD_DIM)
        yb = stick_breaking_attention(qb, kb, vb) * jax.nn.silu(gb)
        y = jnp.concatenate([ya, yb], axis=-1)
        x = x + jnp.einsum('bse,ed->bsd', y, w_out[l])
    return x
```

```cpp
#include <hip/hip_runtime.h>
#include <cstdio>
#include <cstdint>
#include <cmath>
namespace pg8 {
#define PG8_LAS __attribute__((address_space(3)))
typedef unsigned short bf16_t;
typedef short bf16x8 __attribute__((ext_vector_type(8)));
typedef float f32x4 __attribute__((ext_vector_type(4)));
typedef unsigned u32x4 __attribute__((ext_vector_type(4)));
constexpr int BM = 256, BK = 64, HALF = 128, HTB = HALF * BK * 2  , STAGE_BYTES = 8 * HTB, NXCD = 8, WGM = 8;

__host__ __device__ __forceinline__ int lds_byte(int r, int c) { const int st = (r >> 4) * 2 + (c >> 5), rr = r & 15, cc = c & 31, ob = rr * 64 + cc * 2; return st * 1024 + (ob ^ (((ob >> 9) & 1) << 5)); }
__host__ __device__ __forceinline__ void stage_rc(int b, int& R, int& C) { const int st = b / 1024, sb = b % 1024, swz = sb ^ (((sb >> 9) & 1) << 5); R = (st >> 1) * 16 + swz / 64; C = (st & 1) * 32 + (swz % 64) / 2; }
__host__ __device__ __forceinline__ int perm32(int rho) { const int n = rho >> 4, i = rho & 15; return 8 * (i >> 2) + 4 * n + (i & 3); }

struct Unit { int pm, pn; };
struct Gemm { const bf16_t* A; const bf16_t* Bt; int M, N, K; };

struct StaticOrder {
    int nM, nN, nwg, G, c;
    __host__ __device__ void init(int M, int N, int G_, int c_) { nM = M / BM; nN = N / BM; nwg = nM * nN; G = G_; c = c_; }
    __host__ __device__ bool next(int i, Unit& u) const {
        const long L = (long)i * G + c; if (L >= nwg) return false;
        int wgid = (int)L; { const int q = nwg / NXCD, r = nwg % NXCD, xcd = wgid % NXCD, off = wgid / NXCD; wgid = (xcd < r ? xcd * (q + 1) : r * (q + 1) + (xcd - r) * q) + off; }
        const int nig = WGM * nN, gid = wgid / nig, fm = gid * WGM, gsz = (nM - fm) < WGM ? (nM - fm) : WGM;
        u.pm = fm + ((wgid % nig) % gsz); u.pn = (wgid % nig) / gsz; return true;
    }
    __device__ __forceinline__ void a_ready(const Unit&) const {}
    __device__ __forceinline__ void done(const Unit&) const {}
};


__device__ __forceinline__ unsigned cvt_pk_bf16(float lo, float hi) { unsigned r; asm volatile("v_cvt_pk_bf16_f32 %0, %1, %2" : "=v"(r) : "v"(lo), "v"(hi)); return r; }

struct EpiProj {
    static constexpr bool PERM = false, AFTER_DRAIN = false;
    bf16_t* O; int ldc;
    const float* cs;
    const float* qg; const float* kg;
    float qscale;
    __device__ __forceinline__ void operator()(const f32x4 (&acc)[2][2][4][2], const Unit& u, int wr, int wc, int fr, int fq) const {
        const int pn = u.pn;
        const int colb = pn * BM + wc * 64;
        int kind = 0;
        if (pn < 2) kind = 1; else if (pn == 2) kind = (wc < 2) ? 2 : 0; else if (pn == 5 || pn == 6) kind = 3;
        const int row0 = u.pm * BM + wr * 64 + fr;
        if (kind == 1 || kind == 2) {
            const float* gp = (kind == 1) ? qg : kg;
            const float sc = (kind == 1) ? qscale : 1.0f;
            f32x4 gv[2][2];
#pragma unroll
            for (int bj = 0; bj < 2; ++bj)
#pragma unroll
                for (int n = 0; n < 2; ++n) { gv[bj][n] = *(const f32x4*)(gp + 32 * bj + 8 * fq + 4 * n); gv[bj][n] = gv[bj][n] * sc; }
#pragma unroll
            for (int ai = 0; ai < 2; ++ai)
#pragma unroll
                for (int m = 0; m < 4; ++m) {
                    const int row = row0 + ai * HALF + m * 16;
                    const f32x4 c0 = *(const f32x4*)(cs + (size_t)row * 64 + 8 * fq), c1 = *(const f32x4*)(cs + (size_t)row * 64 + 8 * fq + 4);
                    const f32x4 s0 = *(const f32x4*)(cs + (size_t)row * 64 + 32 + 8 * fq), s1 = *(const f32x4*)(cs + (size_t)row * 64 + 32 + 8 * fq + 4);
                    f32x4 v00 = acc[ai][0][m][0], v01 = acc[ai][0][m][1], v10 = acc[ai][1][m][0], v11 = acc[ai][1][m][1];
                    f32x4 q = v00 * v00 + v01 * v01 + v10 * v10 + v11 * v11;
                    float ss = (q[0] + q[1]) + (q[2] + q[3]);
                    ss += __shfl_xor(ss, 16); ss += __shfl_xor(ss, 32);
                    const float rs = 1.0f / sqrtf(ss * (1.0f / 64.0f) + 1e-6f);
                    v00 = v00 * rs * gv[0][0]; v01 = v01 * rs * gv[0][1]; v10 = v10 * rs * gv[1][0]; v11 = v11 * rs * gv[1][1];
                    const f32x4 o00 = v00 * c0 - v10 * s0, o01 = v01 * c1 - v11 * s1, o10 = v10 * c0 + v00 * s0, o11 = v11 * c1 + v01 * s1;
                    bf16_t* rowp = O + (size_t)row * ldc + colb + 8 * fq;
                    u32x4 w0, w1;
                    w0.x = cvt_pk_bf16(o00[0], o00[1]); w0.y = cvt_pk_bf16(o00[2], o00[3]); w0.z = cvt_pk_bf16(o01[0], o01[1]); w0.w = cvt_pk_bf16(o01[2], o01[3]);
                    w1.x = cvt_pk_bf16(o10[0], o10[1]); w1.y = cvt_pk_bf16(o10[2], o10[3]); w1.z = cvt_pk_bf16(o11[0], o11[1]); w1.w = cvt_pk_bf16(o11[2], o11[3]);
                    *(u32x4*)(rowp) = w0; *(u32x4*)(rowp + 32) = w1;
                }
        } else {
            const float sc = (kind == 3) ? qscale : 1.0f;
#pragma unroll
            for (int ai = 0; ai < 2; ++ai)
#pragma unroll
                for (int m = 0; m < 4; ++m) {
                    const int row = row0 + ai * HALF + m * 16;
                    bf16_t* rowp = O + (size_t)row * ldc + colb + 8 * fq;
#pragma unroll
                    for (int bj = 0; bj < 2; ++bj) { const f32x4 v0 = acc[ai][bj][m][0] * sc, v1 = acc[ai][bj][m][1] * sc; u32x4 w;
                        w.x = cvt_pk_bf16(v0[0], v0[1]); w.y = cvt_pk_bf16(v0[2], v0[3]); w.z = cvt_pk_bf16(v1[0], v1[1]); w.w = cvt_pk_bf16(v1[2], v1[3]);
                        *(u32x4*)(rowp + 32 * bj) = w; }
                }
        }
    }
};

struct EpiRes {
    static constexpr bool PERM = false, AFTER_DRAIN = false;
    const float* base; float* C; int ldc;
    __device__ __forceinline__ void operator()(const f32x4 (&acc)[2][2][4][2], const Unit& u, int wr, int wc, int fr, int fq) const {
        const int row0 = u.pm * BM + wr * 64 + fr, col0 = u.pn * BM + wc * 32 + 4 * fq;
#pragma unroll
        for (int ai = 0; ai < 2; ++ai)
#pragma unroll
            for (int m = 0; m < 4; ++m) { const size_t off = (size_t)(row0 + ai * HALF + m * 16) * ldc + col0;
#pragma unroll
                for (int bj = 0; bj < 2; ++bj)
#pragma unroll
                    for (int n = 0; n < 2; ++n) { const f32x4 bs = *(const f32x4*)(base + off + bj * HALF + n * 16); *(f32x4*)(C + off + bj * HALF + n * 16) = bs + acc[ai][bj][m][n]; } }
    }
};
template <class Epi, class Sched, bool ALIGN_EPI = false, bool SP2 = false>
__device__ __forceinline__ void gemm_phase(PG8_LAS unsigned char* lds, const Gemm g, const Sched& S, const Epi& E) {
    const int tid = threadIdx.x, wid = __builtin_amdgcn_readfirstlane(tid >> 6), lane = tid & 63, wr = wid >> 2, wc = wid & 3, fr = lane & 15, fq = lane >> 4;
    const int K = g.K, nt = K / BK;
    unsigned voffA[2], voffB[2];
#pragma unroll
    for (int i = 0; i < 2; ++i) { int R, C; stage_rc(tid * 16 + i * 8192, R, C); const int Rb = Epi::PERM ? ((R & ~31) + perm32(R & 31)) : R;
        voffA[i] = (unsigned)(R * K + C) * 2u; voffB[i] = (unsigned)(Rb * K + C) * 2u; }
    const size_t kstep = (size_t)(BK * 2);
    const size_t hstep = (size_t)HALF * K * 2;
    const size_t tstep = 2 * hstep;
    const unsigned ldsw = (unsigned)wid * 1024u;
    const int aoff = lds_byte(wr * 64 + fr, fq * 8), boff = lds_byte(wc * 32 + fr, fq * 8);
#define PG8_SA(b, h) (((b) * 2 + (h)) * HTB)
#define PG8_SB(b, h) ((4 + (b) * 2 + (h)) * HTB)
#define PG8_STAGE(bufoff, gbase, voff) do { _Pragma("unroll") for (int _i = 0; _i < 2; ++_i) \
        __builtin_amdgcn_global_load_lds((const unsigned*)((const char*)(gbase) + (voff)[_i]), (PG8_LAS unsigned*)(lds + (bufoff) + ldsw + _i * 8192), 16, 0, 0); } while (0)
#define PG8_LDA(dst, b, h) do { _Pragma("unroll") for (int m = 0; m < 4; ++m) _Pragma("unroll") for (int k = 0; k < 2; ++k) dst[m][k] = *(const PG8_LAS bf16x8*)(lds + PG8_SA(b, h) + aoff + m * 2048 + k * 1024); } while (0)
#define PG8_LDB(dst, b, h) do { _Pragma("unroll") for (int n = 0; n < 2; ++n) _Pragma("unroll") for (int k = 0; k < 2; ++k) dst[n][k] = *(const PG8_LAS bf16x8*)(lds + PG8_SB(b, h) + boff + n * 2048 + k * 1024); } while (0)
#define PG8_MMA(ai, bj, At, Bt) do { __builtin_amdgcn_s_setprio(1); _Pragma("unroll") for (int m = 0; m < 4; ++m) _Pragma("unroll") for (int n = 0; n < 2; ++n) _Pragma("unroll") for (int k = 0; k < 2; ++k) \
        acc[ai][bj][m][n] = __builtin_amdgcn_mfma_f32_16x16x32_bf16(Bt[n][k], At[m][k], acc[ai][bj][m][n], 0, 0, 0); __builtin_amdgcn_s_setprio(0); } while (0)
#define PG8_WAIT_V(n) asm volatile("s_waitcnt vmcnt(" #n ")" ::: "memory")
#define PG8_WAIT_L(n) asm volatile("s_waitcnt lgkmcnt(" #n ")" ::: "memory")
#define PG8_BAR __builtin_amdgcn_s_barrier()
#define PG8_SCHED __builtin_amdgcn_sched_barrier(0)
    Unit cur, nxt; int ui = 0;
    if (!S.next(0, cur)) return;
    f32x4 acc[2][2][4][2];
#pragma unroll
    for (int a = 0; a < 2; ++a)
#pragma unroll
        for (int b = 0; b < 2; ++b)
#pragma unroll
            for (int m = 0; m < 4; ++m)
#pragma unroll
                for (int n = 0; n < 2; ++n) acc[a][b][m][n] = (f32x4){0.f, 0.f, 0.f, 0.f};
    bf16x8 At[4][2], B0[2][2], B1[2][2];
    const char* cA = (const char*)g.A + (size_t)cur.pm * tstep; const char* cB = (const char*)g.Bt + (size_t)cur.pn * tstep;
    S.a_ready(cur);
    if constexpr (SP2) {
        PG8_STAGE(PG8_SB(0, 0), cB, voffB); PG8_STAGE(PG8_SB(0, 1), cB + hstep, voffB); PG8_STAGE(PG8_SA(0, 0), cA, voffA); PG8_STAGE(PG8_SA(0, 1), cA + hstep, voffA);
        if (wr == 1) PG8_BAR;
        PG8_WAIT_V(2); PG8_BAR;
        PG8_STAGE(PG8_SB(1, 0), cB + kstep, voffB); PG8_STAGE(PG8_SA(1, 0), cA + kstep, voffA); PG8_STAGE(PG8_SB(1, 1), cB + hstep + kstep, voffB);
        PG8_WAIT_V(6); PG8_BAR;
    } else {
        PG8_STAGE(PG8_SB(0, 0), cB, voffB); PG8_STAGE(PG8_SA(0, 0), cA, voffA); PG8_STAGE(PG8_SB(0, 1), cB + hstep, voffB); PG8_STAGE(PG8_SA(0, 1), cA + hstep, voffA);
        if (wr == 1) PG8_BAR;
        PG8_WAIT_V(4); PG8_BAR;
        PG8_STAGE(PG8_SB(1, 0), cB + kstep, voffB); PG8_STAGE(PG8_SA(1, 0), cA + kstep, voffA); PG8_STAGE(PG8_SB(1, 1), cB + hstep + kstep, voffB);
        PG8_WAIT_V(6); PG8_BAR;
    }
    for (;;) {
        const bool has_next = S.next(ui + 1, nxt);
        const char* nA = has_next ? (const char*)g.A + (size_t)nxt.pm * tstep : cA; const char* nB = has_next ? (const char*)g.Bt + (size_t)nxt.pn * tstep : cB;
        for (int t = 0; t < nt; t += 2) {
            const bool last = (t == nt - 2);
            const char* a1 = cA + (size_t)(t + 1) * kstep;
            const char* a2 = last ? nA : cA + (size_t)(t + 2) * kstep; const char* b2 = last ? nB : cB + (size_t)(t + 2) * kstep;
            const char* a3 = a2 + kstep; const char* b3 = b2 + kstep;
            if (last && has_next) S.a_ready(nxt);
            if constexpr (SP2) {
            PG8_LDB(B0, 0, 0); PG8_LDB(B1, 0, 1); PG8_SCHED; PG8_LDA(At, 0, 0); PG8_STAGE(PG8_SA(1, 1), a1 + hstep, voffA);
            PG8_WAIT_V(8); PG8_WAIT_L(0); PG8_BAR; PG8_MMA(0, 0, At, B0); PG8_MMA(0, 1, At, B1); PG8_BAR; PG8_SCHED;
            PG8_LDA(At, 0, 1); PG8_STAGE(PG8_SB(0, 0), b2, voffB); PG8_STAGE(PG8_SB(0, 1), b2 + hstep, voffB); PG8_STAGE(PG8_SA(0, 0), a2, voffA);
            PG8_WAIT_V(8); PG8_WAIT_L(0); PG8_BAR; PG8_MMA(1, 0, At, B0); PG8_MMA(1, 1, At, B1); PG8_BAR; PG8_SCHED;
            PG8_LDB(B0, 1, 0); PG8_LDB(B1, 1, 1); PG8_SCHED; PG8_LDA(At, 1, 0); PG8_STAGE(PG8_SA(0, 1), a2 + hstep, voffA);
            PG8_WAIT_V(8); PG8_WAIT_L(0); PG8_BAR; PG8_MMA(0, 0, At, B0); PG8_MMA(0, 1, At, B1); PG8_BAR; PG8_SCHED;
            PG8_LDA(At, 1, 1); PG8_STAGE(PG8_SB(1, 0), b3, voffB); PG8_STAGE(PG8_SB(1, 1), b3 + hstep, voffB); PG8_STAGE(PG8_SA(1, 0), a3, voffA);
            PG8_WAIT_V(8); PG8_WAIT_L(0); PG8_BAR; PG8_MMA(1, 0, At, B0); PG8_MMA(1, 1, At, B1); PG8_BAR; PG8_SCHED;
            } else {
            PG8_LDB(B0, 0, 0); PG8_SCHED; PG8_LDA(At, 0, 0); PG8_STAGE(PG8_SA(1, 1), a1 + hstep, voffA);
            PG8_WAIT_L(8); PG8_BAR; PG8_WAIT_L(0); PG8_MMA(0, 0, At, B0); PG8_BAR; PG8_SCHED;
            PG8_LDB(B1, 0, 1); PG8_STAGE(PG8_SB(0, 0), b2, voffB);
            PG8_BAR; PG8_WAIT_L(0); PG8_MMA(0, 1, At, B1); PG8_BAR;
            PG8_LDA(At, 0, 1); PG8_STAGE(PG8_SA(0, 0), a2, voffA);
            PG8_BAR; PG8_WAIT_L(0); PG8_MMA(1, 0, At, B0); PG8_BAR; PG8_SCHED;
            PG8_STAGE(PG8_SB(0, 1), b2 + hstep, voffB);
            PG8_WAIT_V(6); PG8_BAR; PG8_MMA(1, 1, At, B1); PG8_BAR;
            PG8_LDB(B0, 1, 0); PG8_SCHED; PG8_LDA(At, 1, 0); PG8_STAGE(PG8_SA(0, 1), a2 + hstep, voffA);
            PG8_WAIT_L(8); PG8_BAR; PG8_WAIT_L(0); PG8_MMA(0, 0, At, B0); PG8_BAR; PG8_SCHED;
            PG8_LDB(B1, 1, 1); PG8_STAGE(PG8_SB(1, 0), b3, voffB);
            PG8_BAR; PG8_WAIT_L(0); PG8_MMA(0, 1, At, B1); PG8_BAR;
            PG8_LDA(At, 1, 1); PG8_STAGE(PG8_SA(1, 0), a3, voffA);
            PG8_BAR; PG8_WAIT_L(0); PG8_MMA(1, 0, At, B0); PG8_BAR; PG8_SCHED;
            PG8_STAGE(PG8_SB(1, 1), b3 + hstep, voffB);
            PG8_WAIT_V(6); PG8_BAR; PG8_MMA(1, 1, At, B1); PG8_BAR;
            }
        }
        if constexpr (ALIGN_EPI) { if (wr == 0) PG8_BAR; }
        if constexpr (!Epi::AFTER_DRAIN) { E(acc, cur, wr, wc, fr, fq); S.done(cur); }
        if (!has_next) break;
#pragma unroll
        for (int a = 0; a < 2; ++a)
#pragma unroll
            for (int b = 0; b < 2; ++b)
#pragma unroll
                for (int m = 0; m < 4; ++m)
#pragma unroll
                    for (int n = 0; n < 2; ++n) acc[a][b][m][n] = (f32x4){0.f, 0.f, 0.f, 0.f};
        cur = nxt; cA = nA; cB = nB; ++ui;
        if constexpr (ALIGN_EPI) { if (wr == 1) PG8_BAR; }
    }
    PG8_WAIT_V(0);
    if constexpr (!ALIGN_EPI) { if (wr == 0) PG8_BAR; }
    PG8_BAR;
    if constexpr (Epi::AFTER_DRAIN) { E.fused(acc, cur, wr, wc, fr, fq, lds, wid, lane); S.done(cur); }
#undef PG8_SA
#undef PG8_SB
#undef PG8_STAGE
#undef PG8_LDA
#undef PG8_LDB
#undef PG8_MMA
#undef PG8_WAIT_V
#undef PG8_WAIT_L
#undef PG8_BAR
#undef PG8_SCHED
}
}

namespace att {
using bf16x8 = __attribute__((ext_vector_type(8))) short;
using s16x4 = __attribute__((ext_vector_type(4))) short;
using f32x16 = __attribute__((ext_vector_type(16))) float;
using u32x4 = __attribute__((ext_vector_type(4))) unsigned;
typedef unsigned short bf16_t;
constexpr int SEQ = 2048, PP = 3328  , YP = 1024  ;
constexpr int NSLOT = 3, SLOTB = 8192;
constexpr int LDS_K = 0, LDS_V = NSLOT * SLOTB, LDS_FLAG = 2 * NSLOT * SLOTB, LDS_OST = LDS_FLAG + 256, OST_ROW = 144, OST_WAVE = 32 * OST_ROW, LDS_BYTES = LDS_OST + 8 * OST_WAVE;
typedef __attribute__((address_space(3))) const char* lds_cptr;
typedef __attribute__((address_space(3))) char* lds_ptr;
typedef short v4i16_t __attribute__((ext_vector_type(4)));

__device__ __forceinline__ void glds16(const void* gsrc, unsigned lds_dst) { unsigned keep;
    asm volatile("s_mov_b32 %0, m0\n\ts_mov_b32 m0, %2\n\ts_nop 0\n\tglobal_load_lds_dwordx4 %1, off\n\ts_mov_b32 m0, %0" : "=&s"(keep) : "v"(gsrc), "s"(lds_dst) : "memory"); }
typedef float f32x2_t __attribute__((ext_vector_type(2))); typedef __bf16 bf16x2_t __attribute__((ext_vector_type(2)));
__device__ __forceinline__ unsigned cvtpk(float lo, float hi) { f32x2_t v = {lo, hi}; bf16x2_t b = __builtin_convertvector(v, bf16x2_t); return __builtin_bit_cast(unsigned, b); }
__device__ __forceinline__ s16x4 vtr(lds_cptr p) { return __builtin_bit_cast(s16x4, __builtin_amdgcn_ds_read_tr16_b64_v4i16((__attribute__((address_space(3))) v4i16_t*)p)); }
__device__ __forceinline__ float bf2f(unsigned short h) { return __uint_as_float(((unsigned)h) << 16); }
__device__ __forceinline__ float swap_other(float x) {
    auto rr = __builtin_amdgcn_permlane32_swap(__float_as_uint(x), __float_as_uint(x), false, false);
    return (threadIdx.x & 32) ? __uint_as_float(rr[0]) : __uint_as_float(rr[1]);
}
#define ATT_WAIT_BAR(N) asm volatile("s_waitcnt vmcnt(" #N ") lgkmcnt(0)\n\ts_barrier" ::: "memory")

template <bool SB>
__device__ __forceinline__ void attn_unit(int b, int hq, int qb, const bf16_t* PROJ, bf16_t* Y, const float* sinks, char* shm) {
    const int tid = threadIdx.x, lane = tid & 63, r32 = lane & 31, hi = lane >> 5; const int wid = __builtin_amdgcn_readfirstlane(tid >> 6);
    const long rowbase = (long)b * SEQ; const int q0 = qb * 256, Qw = q0 + wid * 32;
    const int qcol = SB ? 1280 + hq * 64 : hq * 64;
    const int kcol = SB ? 1792 + hq * 64 : 512 + (hq >> 2) * 64;
    const int vcol = SB ? 2304 + hq * 64 : 640 + (hq >> 2) * 64;
    const int gcol = SB ? 2816 + hq * 64 : 768 + hq * 64;
    const int ycol = SB ? 512 + hq * 64 : hq * 64;
    const bf16_t* Kh = PROJ + rowbase * PP + kcol; const bf16_t* Vh = PROJ + rowbase * PP + vcol;
    const unsigned lds0 = (unsigned)(uintptr_t)shm;
    const lds_cptr shm3 = (lds_cptr)shm;
    const bf16_t* ksrc = Kh + (long)lane * PP + wid * 8;
    const bf16_t* vsrc = Vh + (long)(16 * (wid & 3) + (lane >> 2)) * PP + (wid >> 2) * 32 + (lane & 3) * 8;
    const unsigned kdst = lds0 + LDS_K + wid * 1024, vdst = lds0 + LDS_V + wid * 1024;
#define ATT_DMA(t, slot) do { glds16(ksrc + (long)(t) * 64 * PP, (unsigned)__builtin_amdgcn_readfirstlane(kdst + (slot))); glds16(vsrc + (long)(t) * 64 * PP, (unsigned)__builtin_amdgcn_readfirstlane(vdst + (slot))); } while (0)
    const int pi = 16 * ((r32 >> 2) & 1) + 4 * (r32 >> 3) + (r32 & 3);
    const lds_cptr kp0 = shm3 + LDS_K + hi * 1024 + pi * 16;
    const lds_cptr vp0 = shm3 + LDS_V + (16 * hi + ((lane & 15) >> 2)) * 64 + ((lane >> 4) & 1) * 32 + (lane & 3) * 8;
    volatile __attribute__((address_space(3))) unsigned* flags = (volatile __attribute__((address_space(3))) unsigned*)(shm3 + LDS_FLAG);
    const int t_hi = 4 * qb + 3, t_lo = SB ? 0 : (4 * qb - 2 > 0 ? 4 * qb - 2 : 0);
    const int td = 4 * qb + (wid >> 1);
    const int tw_lo = SB ? 0 : ((Qw - 127 > 0 ? Qw - 127 : 0) >> 6);
    ATT_DMA(t_hi, 0);
    bf16x8 qr[4];
    { const bf16_t* Qw_p = PROJ + (rowbase + Qw + r32) * PP + qcol + hi * 8;
#pragma unroll
      for (int d0 = 0; d0 < 4; ++d0) qr[d0] = *reinterpret_cast<const bf16x8*>(Qw_p + d0 * 16); }
    f32x16 o[2]; o[0] = f32x16{}; o[1] = f32x16{};
    float m_run = 0.f, l_run = 0.f, carry = 1.0f;
    if (!SB) { m_run = sinks[hq] * 1.4426950408889634f; l_run = hi ? 0.f : 1.0f; }
    bool mydone = false;
    int slot = 0;
    for (int it = 0, t = t_hi; t >= t_lo; ++it, --t) {
        const int nslot = (slot == (NSLOT - 1) * SLOTB) ? 0 : slot + SLOTB;
        if (t > t_lo) { ATT_DMA(t - 1, nslot); ATT_WAIT_BAR(2); } else { ATT_WAIT_BAR(0); }
        if (SB && it > 0) {
            const int fb = ((it - 1) & 1) * 8; unsigned all = 1u;
#pragma unroll
            for (int w = 0; w < 8; ++w) all &= flags[fb + w];
            if (__builtin_amdgcn_readfirstlane(all)) break;
        }
        if (t <= td && t >= tw_lo && !mydone) {
            const lds_cptr kp = kp0 + slot;
            f32x16 p0 = f32x16{}, p1 = f32x16{};
#pragma unroll
            for (int d0 = 0; d0 < 4; ++d0) {
                const bf16x8 k0 = *(const __attribute__((address_space(3))) bf16x8*)(kp + d0 * 2048);
                const bf16x8 k1 = *(const __attribute__((address_space(3))) bf16x8*)(kp + d0 * 2048 + 512);
                p0 = __builtin_amdgcn_mfma_f32_32x32x16_bf16(k0, qr[d0], p0, 0, 0, 0);
                p1 = __builtin_amdgcn_mfma_f32_32x32x16_bf16(k1, qr[d0], p1, 0, 0, 0);
            }
            const int thr = (Qw + r32) - 64 * t - 16 * hi;
            u32x4 pw[4];
            if constexpr (SB) {
                if (t == td) {
#pragma unroll
                    for (int r = 0; r < 16; ++r) { if (r >= thr) p0[r] = -INFINITY; if (r + 32 >= thr) p1[r] = -INFINITY; }
                }
#pragma unroll
                for (int r = 0; r < 16; ++r) { p0[r] = __builtin_amdgcn_rcpf(1.0f + __builtin_amdgcn_exp2f(p0[r])); p1[r] = __builtin_amdgcn_rcpf(1.0f + __builtin_amdgcn_exp2f(p1[r])); }
                float s1 = 1.0f, s0 = 1.0f; f32x16 d0v, d1v;
#pragma unroll
                for (int r = 15; r >= 0; --r) { const float n1 = s1 * p1[r]; d1v[r] = s1 - n1; s1 = n1; const float n0 = s0 * p0[r]; d0v[r] = s0 - n0; s0 = n0; }
                const float T1o = swap_other(s1), T0o = swap_other(s0);
                const float c1 = carry * T1o;
                const float off1 = hi ? carry : c1;
                const float c2 = c1 * s1;
                const float off0 = hi ? c2 : c2 * T0o;
                carry = c2 * (s0 * T0o);
#pragma unroll
                for (int r = 0; r < 16; ++r) { d0v[r] *= off0; d1v[r] *= off1; }
#pragma unroll
                for (int j = 0; j < 4; ++j) { pw[0][j] = cvtpk(d0v[2 * j], d0v[2 * j + 1]); pw[1][j] = cvtpk(d0v[8 + 2 * j], d0v[8 + 2 * j + 1]); pw[2][j] = cvtpk(d1v[2 * j], d1v[2 * j + 1]); pw[3][j] = cvtpk(d1v[8 + 2 * j], d1v[8 + 2 * j + 1]); }
                mydone = __all(carry < 1.17549435e-38f);
            } else {
#pragma unroll
                for (int r = 0; r < 16; ++r) { if (r > thr || r < thr - 127) p0[r] = -INFINITY; if (r + 32 > thr || r + 32 < thr - 127) p1[r] = -INFINITY; }
                float rm = p0[0];
#pragma unroll
                for (int r = 1; r < 16; ++r) rm = fmaxf(rm, p0[r]);
#pragma unroll
                for (int r = 0; r < 16; ++r) rm = fmaxf(rm, p1[r]);
                rm = fmaxf(rm, swap_other(rm));
                const float mnew = fmaxf(m_run, rm), alpha = __builtin_amdgcn_exp2f(m_run - mnew); m_run = mnew;
                float sum = 0.f;
#pragma unroll
                for (int r = 0; r < 16; ++r) { p0[r] = __builtin_amdgcn_exp2f(p0[r] - mnew); p1[r] = __builtin_amdgcn_exp2f(p1[r] - mnew); sum += p0[r] + p1[r]; }
                l_run = l_run * alpha + sum;
#pragma unroll
                for (int r = 0; r < 16; ++r) { o[0][r] *= alpha; o[1][r] *= alpha; }
#pragma unroll
                for (int j = 0; j < 4; ++j) { pw[0][j] = cvtpk(p0[2 * j], p0[2 * j + 1]); pw[1][j] = cvtpk(p0[8 + 2 * j], p0[8 + 2 * j + 1]); pw[2][j] = cvtpk(p1[2 * j], p1[2 * j + 1]); pw[3][j] = cvtpk(p1[8 + 2 * j], p1[8 + 2 * j + 1]); }
            }
            const lds_cptr vp = vp0 + slot;
#pragma unroll
            for (int dh = 0; dh < 2; ++dh)
#pragma unroll
                for (int s = 0; s < 4; ++s) {
                    const s16x4 lo = vtr(vp + dh * 4096 + (s >> 1) * 2048 + (s & 1) * 512), hh = vtr(vp + dh * 4096 + (s >> 1) * 2048 + (s & 1) * 512 + 256);
                    const bf16x8 vf = (bf16x8){lo[0], lo[1], lo[2], lo[3], hh[0], hh[1], hh[2], hh[3]};
                    o[dh] = __builtin_amdgcn_mfma_f32_32x32x16_bf16(vf, __builtin_bit_cast(bf16x8, pw[s]), o[dh], 0, 0, 0);
                }
        }
        if (SB) { if (lane == 0) flags[(it & 1) * 8 + wid] = mydone ? 1u : 0u; }
        slot = nslot;
    }
    ATT_WAIT_BAR(0);
    float inv = 1.0f;
    if (!SB) { const float lt = l_run + swap_other(l_run); inv = 1.0f / lt; }
    lds_ptr stg = (lds_ptr)shm + LDS_OST + wid * OST_WAVE;
    typedef unsigned u32x2_t __attribute__((ext_vector_type(2)));
    { const bf16_t* gp = PROJ + (rowbase + Qw + r32) * PP + gcol + 4 * hi;
#pragma unroll
      for (int dh = 0; dh < 2; ++dh)
#pragma unroll
        for (int g = 0; g < 4; ++g) {
            const u32x2_t gv = *(const u32x2_t*)(gp + 32 * dh + 8 * g);
            float yv[4];
#pragma unroll
            for (int j = 0; j < 4; ++j) {
                const unsigned gw = gv[j >> 1]; const float gf = (j & 1) ? __uint_as_float(gw & 0xffff0000u) : __uint_as_float(gw << 16);
                yv[j] = o[dh][4 * g + j] * inv * gf * __builtin_amdgcn_rcpf(1.0f + __builtin_amdgcn_exp2f(-1.4426950408889634f * gf));
            }
            *(__attribute__((address_space(3))) u32x2_t*)(stg + r32 * OST_ROW + (32 * dh + 8 * g + 4 * hi) * 2) = (u32x2_t){cvtpk(yv[0], yv[1]), cvtpk(yv[2], yv[3])};
        } }
    asm volatile("s_waitcnt lgkmcnt(0)" ::: "memory");
#pragma unroll
    for (int i = 0; i < 4; ++i) {
        const int row = i * 8 + (lane >> 3), ch = lane & 7;
        const u32x4 ov = *(const __attribute__((address_space(3))) u32x4*)(stg + row * OST_ROW + ch * 16);
        *(u32x4*)(Y + (rowbase + Qw + row) * YP + ycol + ch * 8) = ov;
    }
    asm volatile("s_waitcnt lgkmcnt(0)" ::: "memory");
#undef ATT_DMA
}
#undef ATT_WAIT_BAR
}
#define GAS __attribute__((address_space(1)))
#define LAS __attribute__((address_space(3)))
typedef unsigned short bf16;
typedef unsigned v4u __attribute__((ext_vector_type(4)));
typedef float f32x4 __attribute__((ext_vector_type(4)));
typedef short bf16x8 __attribute__((ext_vector_type(8)));
typedef GAS unsigned gu32;
typedef GAS unsigned long long gu64;
#define RLX_AGENT __ATOMIC_RELAXED, __HIP_MEMORY_SCOPE_AGENT
#define LDS_WAIT() asm volatile("s_waitcnt lgkmcnt(0)" ::: "memory")
#define VM_WAIT() asm volatile("s_waitcnt vmcnt(0)" ::: "memory")
__device__ __forceinline__ unsigned long long rt() { return __builtin_amdgcn_s_memrealtime(); }
__device__ __forceinline__ unsigned f2bf(float f) { unsigned u = __builtin_bit_cast(unsigned, f); return (u + 0x7fffu + ((u >> 16) & 1u)) >> 16; }
__device__ __forceinline__ unsigned pk2(float lo, float hi) { return f2bf(lo) | (f2bf(hi) << 16); }

#define XB_TMO      128
#define XB_XCNT(j)  (256  + 64 * (j))
#define XB_XSUB(j)  (1280 + 64 * (j))
#define XB_XGEN(j)  (2304 + 64 * (j))
#define XB_TOP      3328
#define XB_TOPGEN   3392
#define XCD_BAR_WORDS 3456
#define XB_SPIN_CAP (1u << 18)

__device__ __forceinline__ unsigned xb_ld(unsigned* p)              { return __hip_atomic_load(p, __ATOMIC_RELAXED, __HIP_MEMORY_SCOPE_AGENT); }
__device__ __forceinline__ unsigned xb_add(unsigned* p, unsigned v) { return __hip_atomic_fetch_add(p, v, __ATOMIC_RELAXED, __HIP_MEMORY_SCOPE_AGENT); }
__device__ __forceinline__ unsigned xb_xcc_id() { return (unsigned)__builtin_amdgcn_s_getreg((3 << 11) | 20) & 0xFu; }
#define XB_SPIN(cond, bar) do { unsigned _sp = 0; while (cond) { __builtin_amdgcn_s_sleep(1); \
    if ((++_sp & 255u) == 0u) { if (xb_ld(&(bar)[XB_TMO])) break; if (_sp > XB_SPIN_CAP) { atomicAdd(&(bar)[XB_TMO], 1u); break; } } } } while (0)

struct XcdBarrier {
    unsigned* bar; unsigned x;
    volatile LAS unsigned* st;
};

__device__ __forceinline__ XcdBarrier xcd_barrier_post(unsigned* bar, volatile LAS unsigned* st) {
    XcdBarrier b; b.bar = bar; b.x = xb_xcc_id(); b.st = st;
    if (threadIdx.x == 0) (void)xb_add(&bar[XB_XCNT(b.x)], 1u);
    return b;
}
__device__ __forceinline__ void xcd_barrier_complete(unsigned* bar, unsigned x, unsigned& nloc, unsigned& nx) {
    const unsigned G = gridDim.x * gridDim.y * gridDim.z;
    unsigned sum, cnt, mine, sp = 0u;
    for (;;) {
        sum = 0u; cnt = 0u; mine = 0u;
#pragma unroll
        for (unsigned j = 0; j < 16; ++j) { const unsigned c = xb_ld(&bar[XB_XCNT(j)]); sum += c; cnt += (c > 0u) ? 1u : 0u; mine = (j == x) ? c : mine; }
        if (sum == G) break;
        __builtin_amdgcn_s_sleep(1);
        if ((++sp & 255u) == 0u) { if (xb_ld(&bar[XB_TMO])) break; if (sp > XB_SPIN_CAP) { atomicAdd(&bar[XB_TMO], 1u); break; } }
    }
    nloc = mine > 0u ? mine : 1u; nx = cnt > 0u ? cnt : 1u;
}

__device__ __forceinline__ void xcd_barrier(const XcdBarrier& b) {
    asm volatile("s_waitcnt vmcnt(0)" ::: "memory");
    __syncthreads();
    if (threadIdx.x == 0) {
        unsigned* bar = b.bar;
        __builtin_amdgcn_s_waitcnt(0);
        unsigned nloc = b.st[0], nx = b.st[1];
        if (nloc == 0u) { xcd_barrier_complete(bar, b.x, nloc, nx); b.st[0] = nloc; b.st[1] = nx; }
        const unsigned old = xb_add(&bar[XB_XSUB(b.x)], 1u);
        const unsigned gen = old / nloc;
        if (old + 1u == (gen + 1u) * nloc) {
            __builtin_amdgcn_fence(__ATOMIC_RELEASE, "agent");
            asm volatile("s_waitcnt vmcnt(0)" ::: "memory");
            const unsigned og = xb_add(&bar[XB_TOP], 1u);
            const unsigned tg = og / nx;
            if (og + 1u == (tg + 1u) * nx) xb_add(&bar[XB_TOPGEN], 1u);
            else XB_SPIN(xb_ld(&bar[XB_TOPGEN]) == tg, bar);
            __builtin_amdgcn_fence(__ATOMIC_ACQUIRE, "agent");
            xb_add(&bar[XB_XGEN(b.x)], 1u);
            asm volatile("s_waitcnt vmcnt(0)" ::: "memory");
        } else {
            XB_SPIN(xb_ld(&bar[XB_XGEN(b.x)]) == gen, bar);
            __builtin_amdgcn_fence(__ATOMIC_ACQUIRE, "agent");
            asm volatile("s_waitcnt vmcnt(0)" ::: "memory");
        }
    }
    __syncthreads();
}

constexpr int NWAVES = 8;
constexpr int BATCH = 16, SEQ = 2048, D = 1024, M = BATCH * SEQ, NIN = 3328, MIX = 1024;
constexpr float EPS = 1e-6f;
constexpr size_t MiB = 1u << 20;
constexpr size_t WS_CTL = 0, CTL_ZERO_BYTES = 1 * MiB;
constexpr size_t WS_W1T = 2 * MiB;
constexpr size_t WS_W2T = 9 * MiB;
constexpr size_t WS_CS = 12 * MiB;
constexpr size_t WS_XN = 32 * MiB;
constexpr size_t WS_Y = 96 * MiB;
constexpr size_t WS_PROJ = 160 * MiB;
constexpr size_t WS_END = WS_PROJ + (size_t)M * NIN * 2;
constexpr int CW_BAR = 4096;
constexpr int RING_OFF = 0, RING_BYTES = 131072;
constexpr int LDSCTL_OFF = RING_BYTES, MISC_OFF = LDSCTL_OFF + 320;
constexpr int LDS_BYTES = 147456;
static_assert(att::LDS_BYTES <= RING_BYTES, "attention LDS");

struct Frame {
    LAS unsigned char* lds;
    volatile LAS unsigned* MISC;
    gu32* ctl;
    int tid, lane, wave;
    int vcu, G;
};

__device__ __forceinline__ float wave_sum(float v) {
#pragma unroll
    for (int o = 1; o < 64; o <<= 1) v += __shfl_xor(v, o);
    return v;
}
__device__ __forceinline__ int phys_row(int L) { const int t = L & 255, wc = t >> 6, bj = (t >> 5) & 1, fq = (t >> 3) & 3, n = (t >> 2) & 1, j = t & 3; return (L & ~255) + 128 * bj + 32 * wc + 16 * n + 4 * fq + j; }
template <bool PERMUTE>
__device__ __forceinline__ void p0_transpose_item(const float* W, int K, int N, bf16* WT, LAS float* scr, int item, int lane) {
    const int nblk = N / 32, kb = item / nblk, nb = item % nblk, k0 = 64 * kb, n0 = 32 * nb;
#pragma unroll 8
    for (int i = 0; i < 32; ++i) { const int kk = 2 * i + (lane >> 5); scr[kk * 33 + (lane & 31)] = W[(size_t)(k0 + kk) * N + n0 + (lane & 31)]; }
    LDS_WAIT(); asm volatile("" ::: "memory");
    const int c = lane & 7;
#pragma unroll
    for (int j = 0; j < 4; ++j) { const int n = (lane >> 3) + 8 * j; const LAS float* s = scr + (8 * c) * 33 + n;
        v4u o; o.x = pk2(s[0 * 33], s[1 * 33]); o.y = pk2(s[2 * 33], s[3 * 33]); o.z = pk2(s[4 * 33], s[5 * 33]); o.w = pk2(s[6 * 33], s[7 * 33]);
        const int row = PERMUTE ? phys_row(n0 + n) : (n0 + n);
        *(GAS v4u*)(WT + (size_t)row * K + k0 + 8 * c) = o; }
    LDS_WAIT(); asm volatile("" ::: "memory");
}
__device__ __forceinline__ void rms_row_to_bf16(int lane, const float* xrow, const float* gain, bf16* orow) {
    const GAS f32x4* xr = (const GAS f32x4*)xrow + lane; const GAS f32x4* gr = (const GAS f32x4*)gain + lane;
    f32x4 v[4]; float s = 0.f;
#pragma unroll
    for (int j = 0; j < 4; ++j) { v[j] = xr[64 * j]; s += (v[j].x * v[j].x + v[j].y * v[j].y) + (v[j].z * v[j].z + v[j].w * v[j].w); }
    const float rstd = 1.f / sqrtf(wave_sum(s) * (1.f / D) + EPS);
    GAS unsigned long long* o8 = (GAS unsigned long long*)orow + lane;
#pragma unroll
    for (int j = 0; j < 4; ++j) { const f32x4 g = gr[64 * j]; const f32x4 y = v[j] * rstd * g;
        o8[64 * j] = (unsigned long long)pk2(y.x, y.y) | ((unsigned long long)pk2(y.z, y.w) << 32); }
}
__device__ __forceinline__ void p0_prologue(Frame& F, const float* x, const int* pos, const float* gain, const float* w_in, const float* w_out, bf16* W1T, bf16* W2T, float* CS, bf16* XN) {
    LAS float* scr = (LAS float*)(F.lds + RING_OFF + F.wave * 16384);
    const int gw = F.vcu * NWAVES + F.wave, NGW = F.G * NWAVES;
    constexpr int I_1 = (D / 64) * (NIN / 32), I_2 = (MIX / 64) * (D / 32);
    for (int it = gw; it < I_1 + I_2; it += NGW) {
        if (it < I_1) p0_transpose_item<true>(w_in, D, NIN, W1T, scr, it, F.lane);
        else p0_transpose_item<false>(w_out, MIX, D, W2T, scr, it - I_1, F.lane);
    }
    for (int e = gw * 64 + F.lane; e < M * 32; e += NGW * 64) {
        const int m = e >> 5, i = e & 31;
        const float inv_freq = exp2f(-(float)i * (13.287712379549449f / 32.0f));
        const float ang = (float)pos[m] * inv_freq;
        double rev = (double)ang * 0.15915494309189535; rev -= __builtin_rint(rev);
        const float rf = (float)rev;
        CS[(size_t)m * 64 + i] = __builtin_amdgcn_cosf(rf); CS[(size_t)m * 64 + 32 + i] = __builtin_amdgcn_sinf(rf);
    }
    for (int m = gw; m < M; m += NGW) rms_row_to_bf16(F.lane, x + (size_t)m * D, gain, XN + (size_t)m * D);
}

struct Args { const float* x; const int* pos; const float* gain; const float* w_in; const float* qg; const float* kg; const float* sinks; const float* w_out; float* out; unsigned char* ws; };

__global__ void __launch_bounds__(NWAVES * 64, 2) hyb_fwd(Args args) {
    extern __shared__ __attribute__((aligned(16))) unsigned char lds[];
    Frame F;
    F.lds = (LAS unsigned char*)lds;
    F.MISC = (volatile LAS unsigned*)(F.lds + MISC_OFF);
    F.tid = threadIdx.x; F.lane = F.tid & 63; F.wave = __builtin_amdgcn_readfirstlane(F.tid >> 6);
    F.G = gridDim.x; { const int bx = blockIdx.x; F.vcu = (F.G % 8 == 0) ? (bx % 8) * (F.G / 8) + bx / 8 : bx; }
    unsigned char* ws = args.ws;
    F.ctl = (gu32*)(ws + WS_CTL);
    bf16* W1T = (bf16*)(ws + WS_W1T); bf16* W2T = (bf16*)(ws + WS_W2T); float* CS = (float*)(ws + WS_CS);
    bf16* XN = (bf16*)(ws + WS_XN); bf16* YB = (bf16*)(ws + WS_Y); bf16* PROJ = (bf16*)(ws + WS_PROJ);
    for (int u = F.tid; u < (LDS_BYTES - LDSCTL_OFF) / 4; u += NWAVES * 64) ((LAS unsigned*)(F.lds + LDSCTL_OFF))[u] = 0u;
    __syncthreads();
    XcdBarrier bar = xcd_barrier_post((unsigned*)(F.ctl + CW_BAR), F.MISC + 8);

    p0_prologue(F, args.x, args.pos, args.gain, args.w_in, args.w_out, W1T, W2T, CS, XN);
    xcd_barrier(bar);

    {
        pg8::Gemm g{XN, W1T, M, NIN, D}; pg8::StaticOrder S; S.init(M, NIN, F.G, (int)blockIdx.x);
        pg8::EpiProj E{PROJ, NIN, CS, args.qg, args.kg, 0.125f * 1.4426950408889634f};
        pg8::gemm_phase<pg8::EpiProj, pg8::StaticOrder, true, true>(F.lds + RING_OFF, g, S, E);
    }
    xcd_barrier(bar);

    {
        char* shm = (char*)lds + RING_OFF;
        for (int i = 0; i < 8; ++i) {
            const int n = (i >> 1) * F.G + F.vcu;
            if (n >= 1024) continue;
            const int qb = ((n & 7) + (i >> 1)) & 7, hq = (n >> 3) & 7, b = n >> 6;
            if (i & 1) att::attn_unit<false>(b, hq, qb, PROJ, YB, args.sinks, shm);
            else att::attn_unit<true>(b, hq, qb, PROJ, YB, args.sinks, shm);
        }
    }
    xcd_barrier(bar);

    {
        pg8::Gemm g{YB, W2T, M, D, MIX}; pg8::StaticOrder S; S.init(M, D, F.G, (int)blockIdx.x);
        pg8::EpiRes E{args.x, args.out, D};
        pg8::gemm_phase<pg8::EpiRes, pg8::StaticOrder, true, true>(F.lds + RING_OFF, g, S, E);
    }
}

extern "C" void kernel_launch(void* const* d_in, const int* in_sizes, int n_in, void* d_out, int out_size, void* d_ws, size_t ws_size, hipStream_t stream) {
    static int grid = 0;
    if (grid == 0) {
        if (n_in != 8 || in_sizes[0] != M * D || out_size != M * D || ws_size < WS_END) { fprintf(stderr, "kernel_launch: unexpected shapes (n_in %d, in0 %d, out %d, ws %zu < %zu); nothing launched\n", n_in, n_in > 0 ? in_sizes[0] : -1, out_size, ws_size, (size_t)WS_END); grid = -1; return; }
        int dev = 0, cus = 0, per_cu = 0;
        if (hipGetDevice(&dev) != hipSuccess || hipDeviceGetAttribute(&cus, hipDeviceAttributeMultiprocessorCount, dev) != hipSuccess) { grid = -1; return; }
        if (hipFuncSetAttribute((const void*)hyb_fwd, hipFuncAttributeMaxDynamicSharedMemorySize, LDS_BYTES) != hipSuccess) { fprintf(stderr, "kernel_launch: hipFuncSetAttribute failed\n"); grid = -1; return; }
        if (hipOccupancyMaxActiveBlocksPerMultiprocessor(&per_cu, (const void*)hyb_fwd, NWAVES * 64, LDS_BYTES) != hipSuccess || per_cu < 1) { fprintf(stderr, "kernel_launch: occupancy query says %d blocks per CU; nothing launched\n", per_cu); (void)hipGetLastError(); grid = -1; return; }
        grid = cus;
        if (grid % 8 != 0 || grid > 1024) { fprintf(stderr, "kernel_launch: unexpected CU count %d\n", cus); }
    }
    if (grid < 0) return;
    if (hipMemsetAsync((char*)d_ws + WS_CTL, 0, CTL_ZERO_BYTES, stream) != hipSuccess) { fprintf(stderr, "kernel_launch: memset failed\n"); return; }
    Args a{};
    a.x = (const float*)d_in[0]; a.pos = (const int*)d_in[1]; a.gain = (const float*)d_in[2]; a.w_in = (const float*)d_in[3];
    a.qg = (const float*)d_in[4]; a.kg = (const float*)d_in[5]; a.sinks = (const float*)d_in[6]; a.w_out = (const float*)d_in[7];
    a.out = (float*)d_out; a.ws = (unsigned char*)d_ws;
    hipLaunchKernelGGL(hyb_fwd, dim3(grid), dim3(NWAVES * 64), LDS_BYTES, stream, a);
    const hipError_t le = hipPeekAtLastError();
    if (le != hipSuccess) fprintf(stderr, "kernel_launch: launch failed: %s\n", hipGetErrorName(le));
}
```

```cpp
#include <hip/hip_runtime.h>
#include <cstdio>
#include <cstdint>
#include <cmath>
namespace pg8 {
#define PG8_LAS __attribute__((address_space(3)))
typedef unsigned short bf16_t;
typedef short bf16x8 __attribute__((ext_vector_type(8)));
typedef float f32x4 __attribute__((ext_vector_type(4)));
typedef unsigned u32x4 __attribute__((ext_vector_type(4)));
constexpr int BM = 256, BK = 64, HALF = 128, HTB = HALF * BK * 2  , STAGE_BYTES = 8 * HTB, NXCD = 8, WGM = 8;

__host__ __device__ __forceinline__ int lds_byte(int r, int c) { const int st = (r >> 4) * 2 + (c >> 5), rr = r & 15, cc = c & 31, ob = rr * 64 + cc * 2; return st * 1024 + (ob ^ (((ob >> 9) & 1) << 5)); }
__host__ __device__ __forceinline__ void stage_rc(int b, int& R, int& C) { const int st = b / 1024, sb = b % 1024, swz = sb ^ (((sb >> 9) & 1) << 5); R = (st >> 1) * 16 + swz / 64; C = (st & 1) * 32 + (swz % 64) / 2; }
__host__ __device__ __forceinline__ int perm32(int rho) { const int n = rho >> 4, i = rho & 15; return 8 * (i >> 2) + 4 * n + (i & 3); }

struct Unit { int pm, pn; };
struct Gemm { const bf16_t* A; const bf16_t* Bt; int M, N, K; };

struct StaticOrder {
    int nM, nN, nwg, G, c;
    __host__ __device__ void init(int M, int N, int G_, int c_) { nM = M / BM; nN = N / BM; nwg = nM * nN; G = G_; c = c_; }
    __host__ __device__ bool next(int i, Unit& u) const {
        const long L = (long)i * G + c; if (L >= nwg) return false;
        int wgid = (int)L; { const int q = nwg / NXCD, r = nwg % NXCD, xcd = wgid % NXCD, off = wgid / NXCD; wgid = (xcd < r ? xcd * (q + 1) : r * (q + 1) + (xcd - r) * q) + off; }
        const int nig = WGM * nN, gid = wgid / nig, fm = gid * WGM, gsz = (nM - fm) < WGM ? (nM - fm) : WGM;
        u.pm = fm + ((wgid % nig) % gsz); u.pn = (wgid % nig) / gsz; return true;
    }
    __device__ __forceinline__ void a_ready(const Unit&) const {}
    __device__ __forceinline__ void done(const Unit&) const {}
};


__device__ __forceinline__ unsigned cvt_pk_bf16(float lo, float hi) { unsigned r; asm volatile("v_cvt_pk_bf16_f32 %0, %1, %2" : "=v"(r) : "v"(lo), "v"(hi)); return r; }

struct EpiProj {
    static constexpr bool PERM = false, AFTER_DRAIN = false;
    bf16_t* O; int ldc;
    const float* cs;
    const float* qg; const float* kg;
    float qscale;
    __device__ __forceinline__ void operator()(const f32x4 (&acc)[2][2][4][2], const Unit& u, int wr, int wc, int fr, int fq) const {
        const int pn = u.pn;
        const int colb = pn * BM + wc * 64;
        int kind = 0;
        if (pn < 2) kind = 1; else if (pn == 2) kind = (wc < 2) ? 2 : 0; else if (pn == 5 || pn == 6) kind = 3;
        const int row0 = u.pm * BM + wr * 64 + fr;
        if (kind == 1 || kind == 2) {
            const float* gp = (kind == 1) ? qg : kg;
            const float sc = (kind == 1) ? qscale : 1.0f;
            f32x4 gv[2][2];
#pragma unroll
            for (int bj = 0; bj < 2; ++bj)
#pragma unroll
                for (int n = 0; n < 2; ++n) { gv[bj][n] = *(const f32x4*)(gp + 32 * bj + 8 * fq + 4 * n); gv[bj][n] = gv[bj][n] * sc; }
#pragma unroll
            for (int ai = 0; ai < 2; ++ai)
#pragma unroll
                for (int m = 0; m < 4; ++m) {
                    const int row = row0 + ai * HALF + m * 16;
                    const f32x4 c0 = *(const f32x4*)(cs + (size_t)row * 64 + 8 * fq), c1 = *(const f32x4*)(cs + (size_t)row * 64 + 8 * fq + 4);
                    const f32x4 s0 = *(const f32x4*)(cs + (size_t)row * 64 + 32 + 8 * fq), s1 = *(const f32x4*)(cs + (size_t)row * 64 + 32 + 8 * fq + 4);
                    f32x4 v00 = acc[ai][0][m][0], v01 = acc[ai][0][m][1], v10 = acc[ai][1][m][0], v11 = acc[ai][1][m][1];
                    f32x4 q = v00 * v00 + v01 * v01 + v10 * v10 + v11 * v11;
                    float ss = (q[0] + q[1]) + (q[2] + q[3]);
                    ss += __shfl_xor(ss, 16); ss += __shfl_xor(ss, 32);
                    const float rs = 1.0f / sqrtf(ss * (1.0f / 64.0f) + 1e-6f);
                    v00 = v00 * rs * gv[0][0]; v01 = v01 * rs * gv[0][1]; v10 = v10 * rs * gv[1][0]; v11 = v11 * rs * gv[1][1];
                    const f32x4 o00 = v00 * c0 - v10 * s0, o01 = v01 * c1 - v11 * s1, o10 = v10 * c0 + v00 * s0, o11 = v11 * c1 + v01 * s1;
                    bf16_t* rowp = O + (size_t)row * ldc + colb + 8 * fq;
                    u32x4 w0, w1;
                    w0.x = cvt_pk_bf16(o00[0], o00[1]); w0.y = cvt_pk_bf16(o00[2], o00[3]); w0.z = cvt_pk_bf16(o01[0], o01[1]); w0.w = cvt_pk_bf16(o01[2], o01[3]);
                    w1.x = cvt_pk_bf16(o10[0], o10[1]); w1.y = cvt_pk_bf16(o10[2], o10[3]); w1.z = cvt_pk_bf16(o11[0], o11[1]); w1.w = cvt_pk_bf16(o11[2], o11[3]);
                    *(u32x4*)(rowp) = w0; *(u32x4*)(rowp + 32) = w1;
                }
        } else {
            const float sc = (kind == 3) ? qscale : 1.0f;
#pragma unroll
            for (int ai = 0; ai < 2; ++ai)
#pragma unroll
                for (int m = 0; m < 4; ++m) {
                    const int row = row0 + ai * HALF + m * 16;
                    bf16_t* rowp = O + (size_t)row * ldc + colb + 8 * fq;
#pragma unroll
                    for (int bj = 0; bj < 2; ++bj) { const f32x4 v0 = acc[ai][bj][m][0] * sc, v1 = acc[ai][bj][m][1] * sc; u32x4 w;
                        w.x = cvt_pk_bf16(v0[0], v0[1]); w.y = cvt_pk_bf16(v0[2], v0[3]); w.z = cvt_pk_bf16(v1[0], v1[1]); w.w = cvt_pk_bf16(v1[2], v1[3]);
                        *(u32x4*)(rowp + 32 * bj) = w; }
                }
        }
    }
};

struct EpiRes {
    static constexpr bool PERM = false, AFTER_DRAIN = false;
    const float* base; float* C; int ldc;
    __device__ __forceinline__ void operator()(const f32x4 (&acc)[2][2][4][2], const Unit& u, int wr, int wc, int fr, int fq) const {
        const int row0 = u.pm * BM + wr * 64 + fr, col0 = u.pn * BM + wc * 32 + 4 * fq;
#pragma unroll
        for (int ai = 0; ai < 2; ++ai)
#pragma unroll
            for (int m = 0; m < 4; ++m) { const size_t off = (size_t)(row0 + ai * HALF + m * 16) * ldc + col0;
#pragma unroll
                for (int bj = 0; bj < 2; ++bj)
#pragma unroll
                    for (int n = 0; n < 2; ++n) { const f32x4 bs = *(const f32x4*)(base + off + bj * HALF + n * 16); *(f32x4*)(C + off + bj * HALF + n * 16) = bs + acc[ai][bj][m][n]; } }
    }
};
template <class Epi, class Sched, bool ALIGN_EPI = false, bool SP2 = false>
__device__ __forceinline__ void gemm_phase(PG8_LAS unsigned char* lds, const Gemm g, const Sched& S, const Epi& E) {
    const int tid = threadIdx.x, wid = __builtin_amdgcn_readfirstlane(tid >> 6), lane = tid & 63, wr = wid >> 2, wc = wid & 3, fr = lane & 15, fq = lane >> 4;
    const int K = g.K, nt = K / BK;
    unsigned voffA[2], voffB[2];
#pragma unroll
    for (int i = 0; i < 2; ++i) { int R, C; stage_rc(tid * 16 + i * 8192, R, C); const int Rb = Epi::PERM ? ((R & ~31) + perm32(R & 31)) : R;
        voffA[i] = (unsigned)(R * K + C) * 2u; voffB[i] = (unsigned)(Rb * K + C) * 2u; }
    const size_t kstep = (size_t)(BK * 2);
    const size_t hstep = (size_t)HALF * K * 2;
    const size_t tstep = 2 * hstep;
    const unsigned ldsw = (unsigned)wid * 1024u;
    const int aoff = lds_byte(wr * 64 + fr, fq * 8), boff = lds_byte(wc * 32 + fr, fq * 8);
#define PG8_SA(b, h) (((b) * 2 + (h)) * HTB)
#define PG8_SB(b, h) ((4 + (b) * 2 + (h)) * HTB)
#define PG8_STAGE(bufoff, gbase, voff) do { _Pragma("unroll") for (int _i = 0; _i < 2; ++_i) \
        __builtin_amdgcn_global_load_lds((const unsigned*)((const char*)(gbase) + (voff)[_i]), (PG8_LAS unsigned*)(lds + (bufoff) + ldsw + _i * 8192), 16, 0, 0); } while (0)
#define PG8_LDA(dst, b, h) do { _Pragma("unroll") for (int m = 0; m < 4; ++m) _Pragma("unroll") for (int k = 0; k < 2; ++k) dst[m][k] = *(const PG8_LAS bf16x8*)(lds + PG8_SA(b, h) + aoff + m * 2048 + k * 1024); } while (0)
#define PG8_LDB(dst, b, h) do { _Pragma("unroll") for (int n = 0; n < 2; ++n) _Pragma("unroll") for (int k = 0; k < 2; ++k) dst[n][k] = *(const PG8_LAS bf16x8*)(lds + PG8_SB(b, h) + boff + n * 2048 + k * 1024); } while (0)
#define PG8_MMA(ai, bj, At, Bt) do { __builtin_amdgcn_s_setprio(1); _Pragma("unroll") for (int m = 0; m < 4; ++m) _Pragma("unroll") for (int n = 0; n < 2; ++n) _Pragma("unroll") for (int k = 0; k < 2; ++k) \
        acc[ai][bj][m][n] = __builtin_amdgcn_mfma_f32_16x16x32_bf16(Bt[n][k], At[m][k], acc[ai][bj][m][n], 0, 0, 0); __builtin_amdgcn_s_setprio(0); } while (0)
#define PG8_WAIT_V(n) asm volatile("s_waitcnt vmcnt(" #n ")" ::: "memory")
#define PG8_WAIT_L(n) asm volatile("s_waitcnt lgkmcnt(" #n ")" ::: "memory")
#define PG8_BAR __builtin_amdgcn_s_barrier()
#define PG8_SCHED __builtin_amdgcn_sched_barrier(0)
    Unit cur, nxt; int ui = 0;
    if (!S.next(0, cur)) return;
    f32x4 acc[2][2][4][2];
#pragma unroll
    for (int a = 0; a < 2; ++a)
#pragma unroll
        for (int b = 0; b < 2; ++b)
#pragma unroll
            for (int m = 0; m < 4; ++m)
#pragma unroll
                for (int n = 0; n < 2; ++n) acc[a][b][m][n] = (f32x4){0.f, 0.f, 0.f, 0.f};
    bf16x8 At[4][2], B0[2][2], B1[2][2];
    const char* cA = (const char*)g.A + (size_t)cur.pm * tstep; const char* cB = (const char*)g.Bt + (size_t)cur.pn * tstep;
    S.a_ready(cur);
    if constexpr (SP2) {
        PG8_STAGE(PG8_SB(0, 0), cB, voffB); PG8_STAGE(PG8_SB(0, 1), cB + hstep, voffB); PG8_STAGE(PG8_SA(0, 0), cA, voffA); PG8_STAGE(PG8_SA(0, 1), cA + hstep, voffA);
        if (wr == 1) PG8_BAR;
        PG8_WAIT_V(2); PG8_BAR;
        PG8_STAGE(PG8_SB(1, 0), cB + kstep, voffB); PG8_STAGE(PG8_SA(1, 0), cA + kstep, voffA); PG8_STAGE(PG8_SB(1, 1), cB + hstep + kstep, voffB);
        PG8_WAIT_V(6); PG8_BAR;
    } else {
        PG8_STAGE(PG8_SB(0, 0), cB, voffB); PG8_STAGE(PG8_SA(0, 0), cA, voffA); PG8_STAGE(PG8_SB(0, 1), cB + hstep, voffB); PG8_STAGE(PG8_SA(0, 1), cA + hstep, voffA);
        if (wr == 1) PG8_BAR;
        PG8_WAIT_V(4); PG8_BAR;
        PG8_STAGE(PG8_SB(1, 0), cB + kstep, voffB); PG8_STAGE(PG8_SA(1, 0), cA + kstep, voffA); PG8_STAGE(PG8_SB(1, 1), cB + hstep + kstep, voffB);
        PG8_WAIT_V(6); PG8_BAR;
    }
    for (;;) {
        const bool has_next = S.next(ui + 1, nxt);
        const char* nA = has_next ? (const char*)g.A + (size_t)nxt.pm * tstep : cA; const char* nB = has_next ? (const char*)g.Bt + (size_t)nxt.pn * tstep : cB;
        for (int t = 0; t < nt; t += 2) {
            const bool last = (t == nt - 2);
            const char* a1 = cA + (size_t)(t + 1) * kstep;
            const char* a2 = last ? nA : cA + (size_t)(t + 2) * kstep; const char* b2 = last ? nB : cB + (size_t)(t + 2) * kstep;
            const char* a3 = a2 + kstep; const char* b3 = b2 + kstep;
            if (last && has_next) S.a_ready(nxt);
            if constexpr (SP2) {
            PG8_LDB(B0, 0, 0); PG8_LDB(B1, 0, 1); PG8_SCHED; PG8_LDA(At, 0, 0); PG8_STAGE(PG8_SA(1, 1), a1 + hstep, voffA);
            PG8_WAIT_V(8); PG8_WAIT_L(0); PG8_BAR; PG8_MMA(0, 0, At, B0); PG8_MMA(0, 1, At, B1); PG8_BAR; PG8_SCHED;
            PG8_LDA(At, 0, 1); PG8_STAGE(PG8_SB(0, 0), b2, voffB); PG8_STAGE(PG8_SB(0, 1), b2 + hstep, voffB); PG8_STAGE(PG8_SA(0, 0), a2, voffA);
            PG8_WAIT_V(8); PG8_WAIT_L(0); PG8_BAR; PG8_MMA(1, 0, At, B0); PG8_MMA(1, 1, At, B1); PG8_BAR; PG8_SCHED;
            PG8_LDB(B0, 1, 0); PG8_LDB(B1, 1, 1); PG8_SCHED; PG8_LDA(At, 1, 0); PG8_STAGE(PG8_SA(0, 1), a2 + hstep, voffA);
            PG8_WAIT_V(8); PG8_WAIT_L(0); PG8_BAR; PG8_MMA(0, 0, At, B0); PG8_MMA(0, 1, At, B1); PG8_BAR; PG8_SCHED;
            PG8_LDA(At, 1, 1); PG8_STAGE(PG8_SB(1, 0), b3, voffB); PG8_STAGE(PG8_SB(1, 1), b3 + hstep, voffB); PG8_STAGE(PG8_SA(1, 0), a3, voffA);
            PG8_WAIT_V(8); PG8_WAIT_L(0); PG8_BAR; PG8_MMA(1, 0, At, B0); PG8_MMA(1, 1, At, B1); PG8_BAR; PG8_SCHED;
            } else {
            PG8_LDB(B0, 0, 0); PG8_SCHED; PG8_LDA(At, 0, 0); PG8_STAGE(PG8_SA(1, 1), a1 + hstep, voffA);
            PG8_WAIT_L(8); PG8_BAR; PG8_WAIT_L(0); PG8_MMA(0, 0, At, B0); PG8_BAR; PG8_SCHED;
            PG8_LDB(B1, 0, 1); PG8_STAGE(PG8_SB(0, 0), b2, voffB);
            PG8_BAR; PG8_WAIT_L(0); PG8_MMA(0, 1, At, B1); PG8_BAR;
            PG8_LDA(At, 0, 1); PG8_STAGE(PG8_SA(0, 0), a2, voffA);
            PG8_BAR; PG8_WAIT_L(0); PG8_MMA(1, 0, At, B0); PG8_BAR; PG8_SCHED;
            PG8_STAGE(PG8_SB(0, 1), b2 + hstep, voffB);
            PG8_WAIT_V(6); PG8_BAR; PG8_MMA(1, 1, At, B1); PG8_BAR;
            PG8_LDB(B0, 1, 0); PG8_SCHED; PG8_LDA(At, 1, 0); PG8_STAGE(PG8_SA(0, 1), a2 + hstep, voffA);
            PG8_WAIT_L(8); PG8_BAR; PG8_WAIT_L(0); PG8_MMA(0, 0, At, B0); PG8_BAR; PG8_SCHED;
            PG8_LDB(B1, 1, 1); PG8_STAGE(PG8_SB(1, 0), b3, voffB);
            PG8_BAR; PG8_WAIT_L(0); PG8_MMA(0, 1, At, B1); PG8_BAR;
            PG8_LDA(At, 1, 1); PG8_STAGE(PG8_SA(1, 0), a3, voffA);
            PG8_BAR; PG8_WAIT_L(0); PG8_MMA(1, 0, At, B0); PG8_BAR; PG8_SCHED;
            PG8_STAGE(PG8_SB(1, 1), b3 + hstep, voffB);
            PG8_WAIT_V(6); PG8_BAR; PG8_MMA(1, 1, At, B1); PG8_BAR;
            }
        }
        if constexpr (ALIGN_EPI) { if (wr == 0) PG8_BAR; }
        if constexpr (!Epi::AFTER_DRAIN) { E(acc, cur, wr, wc, fr, fq); S.done(cur); }
        if (!has_next) break;
#pragma unroll
        for (int a = 0; a < 2; ++a)
#pragma unroll
            for (int b = 0; b < 2; ++b)
#pragma unroll
                for (int m = 0; m < 4; ++m)
#pragma unroll
                    for (int n = 0; n < 2; ++n) acc[a][b][m][n] = (f32x4){0.f, 0.f, 0.f, 0.f};
        cur = nxt; cA = nA; cB = nB; ++ui;
        if constexpr (ALIGN_EPI) { if (wr == 1) PG8_BAR; }
    }
    PG8_WAIT_V(0);
    if constexpr (!ALIGN_EPI) { if (wr == 0) PG8_BAR; }
    PG8_BAR;
    if constexpr (Epi::AFTER_DRAIN) { E.fused(acc, cur, wr, wc, fr, fq, lds, wid, lane); S.done(cur); }
#undef PG8_SA
#undef PG8_SB
#undef PG8_STAGE
#undef PG8_LDA
#undef PG8_LDB
#undef PG8_MMA
#undef PG8_WAIT_V
#undef PG8_WAIT_L
#undef PG8_BAR
#undef PG8_SCHED
}
}

namespace att {
using bf16x8 = __attribute__((ext_vector_type(8))) short;
using s16x4 = __attribute__((ext_vector_type(4))) short;
using f32x16 = __attribute__((ext_vector_type(16))) float;
using u32x4 = __attribute__((ext_vector_type(4))) unsigned;
typedef unsigned u32x2_t __attribute__((ext_vector_type(2)));
typedef unsigned short bf16_t;
constexpr int SEQ = 2048, PP = 3328  , YP = 1024  ;
#ifndef REP_DMA
#define REP_DMA 1
#endif
#ifndef REP_CMP
#define REP_CMP 1
#endif
#ifndef ATT_NSLOT
#define ATT_NSLOT 7
#endif
constexpr int NSLOT = ATT_NSLOT, SLOTB = 16384  , STG_OFF = 7 * SLOTB  , LDS_BYTES = STG_OFF + 8 * 4096, FLAG_OFF = LDS_BYTES  ;
static_assert(NSLOT <= 7, "window slots");
typedef __attribute__((address_space(3))) const char* lds_cptr;
typedef short v4i16_t __attribute__((ext_vector_type(4)));

__device__ __forceinline__ void glds16(const void* gsrc, unsigned lds_dst) { unsigned keep;
    asm volatile("s_mov_b32 %0, m0\n\ts_mov_b32 m0, %2\n\ts_nop 0\n\tglobal_load_lds_dwordx4 %1, off\n\ts_mov_b32 m0, %0" : "=&s"(keep) : "v"(gsrc), "s"(lds_dst) : "memory"); }
typedef float f32x2_t __attribute__((ext_vector_type(2))); typedef __bf16 bf16x2_t __attribute__((ext_vector_type(2)));
__device__ __forceinline__ unsigned cvtpk(float lo, float hi) { f32x2_t v = {lo, hi}; bf16x2_t b = __builtin_convertvector(v, bf16x2_t); return __builtin_bit_cast(unsigned, b); }
__device__ __forceinline__ s16x4 vtr(lds_cptr p) { return __builtin_bit_cast(s16x4, __builtin_amdgcn_ds_read_tr16_b64_v4i16((__attribute__((address_space(3))) v4i16_t*)p)); }
__device__ __forceinline__ float swap_other(float x) {
    auto rr = __builtin_amdgcn_permlane32_swap(__float_as_uint(x), __float_as_uint(x), false, false);
    return (threadIdx.x & 32) ? __uint_as_float(rr[0]) : __uint_as_float(rr[1]);
}
struct SrcLds {
    lds_cptr kb, vp;
    __device__ __forceinline__ bf16x8 k(int d0, int half) const {
        const unsigned a = ((unsigned)(uintptr_t)kb ^ (unsigned)(d0 << 5)) + half * 4096;
        return *(const __attribute__((address_space(3))) bf16x8*)(uintptr_t)a; }
    __device__ __forceinline__ bf16x8 v(int dh, int s) const {
        const s16x4 lo = vtr(vp + dh * 4096 + (s >> 1) * 2048 + (s & 1) * 512), hh = vtr(vp + dh * 4096 + (s >> 1) * 2048 + (s & 1) * 512 + 256);
        return (bf16x8){lo[0], lo[1], lo[2], lo[3], hh[0], hh[1], hh[2], hh[3]};
    }
};
template <class Src> __device__ __forceinline__ void load_k(const Src& S, bf16x8 (&kf)[8]) {
#pragma unroll
    for (int d0 = 0; d0 < 4; ++d0) { kf[2 * d0] = S.k(d0, 0); kf[2 * d0 + 1] = S.k(d0, 1); }
}
template <class Src> __device__ __forceinline__ void load_v(const Src& S, bf16x8 (&vf)[8]) {
#pragma unroll
    for (int dh = 0; dh < 2; ++dh)
#pragma unroll
        for (int s = 0; s < 4; ++s) vf[4 * dh + s] = S.v(dh, s);
}
__device__ __forceinline__ void qk_mma(const bf16x8 (&kf)[8], const bf16x8 (&qr)[4], f32x16& p0, f32x16& p1) {
    p0 = f32x16{}; p1 = f32x16{};
#pragma unroll
    for (int d0 = 0; d0 < 4; ++d0) {
        p0 = __builtin_amdgcn_mfma_f32_32x32x16_bf16(kf[2 * d0], qr[d0], p0, 0, 0, 0);
        p1 = __builtin_amdgcn_mfma_f32_32x32x16_bf16(kf[2 * d0 + 1], qr[d0], p1, 0, 0, 0);
    }
}
__device__ __forceinline__ void pv_mma(const bf16x8 (&vf)[8], const u32x4 (&pw)[4], f32x16 (&o)[2]) {
#pragma unroll
    for (int s = 0; s < 4; ++s) {
        o[0] = __builtin_amdgcn_mfma_f32_32x32x16_bf16(vf[s], __builtin_bit_cast(bf16x8, pw[s]), o[0], 0, 0, 0);
        o[1] = __builtin_amdgcn_mfma_f32_32x32x16_bf16(vf[4 + s], __builtin_bit_cast(bf16x8, pw[s]), o[1], 0, 0, 0);
    }
}
#define ATT_MASK_GT(p, thr, IDX, ninf) asm("v_cmp_gt_i32_e32 vcc, " #IDX ", %1\n\tv_cndmask_b32_e32 %0, %0, %2, vcc" : "+v"(p) : "v"(thr), "v"(ninf) : "vcc")
#define ATT_MASK_LE(p, thr, IDX, ninf) asm("v_cmp_le_i32_e32 vcc, " #IDX ", %1\n\tv_cndmask_b32_e32 %0, %0, %2, vcc" : "+v"(p) : "v"(thr), "v"(ninf) : "vcc")
#define ATT_MASK16(M, P, thr, ninf) do { M(P[0], thr, 0, ninf); M(P[1], thr, 1, ninf); M(P[2], thr, 2, ninf); M(P[3], thr, 3, ninf); M(P[4], thr, 4, ninf); M(P[5], thr, 5, ninf); M(P[6], thr, 6, ninf); M(P[7], thr, 7, ninf); \
    M(P[8], thr, 8, ninf); M(P[9], thr, 9, ninf); M(P[10], thr, 10, ninf); M(P[11], thr, 11, ninf); M(P[12], thr, 12, ninf); M(P[13], thr, 13, ninf); M(P[14], thr, 14, ninf); M(P[15], thr, 15, ninf); } while (0)
__device__ __forceinline__ void fill16(f32x16& p, float v) {
#pragma unroll
    for (int r = 0; r < 16; ++r) p[r] = v;
}
template <bool KEEP_SELF> __device__ __forceinline__ void mask_diag(f32x16& p0, f32x16& p1, bool odd, int thrp) {
    const float ninf = -INFINITY; const int th = KEEP_SELF ? thrp : thrp - 1;
    if (odd) { ATT_MASK16(ATT_MASK_GT, p1, th, ninf); } else { ATT_MASK16(ATT_MASK_GT, p0, th, ninf); fill16(p1, ninf); }
}
__device__ __forceinline__ void mask_low(f32x16& p0, f32x16& p1, bool odd, int thrp) {
    const float ninf = -INFINITY;
    if (odd) { fill16(p0, ninf); ATT_MASK16(ATT_MASK_LE, p1, thrp, ninf); } else { ATT_MASK16(ATT_MASK_LE, p0, thrp, ninf); }
}
__device__ __forceinline__ void sb_elem(f32x16& p0, f32x16& p1, bool diag, bool odd, int thrp, int hi, float& carry, u32x4 (&pw)[4]) {
    if (diag) mask_diag<false>(p0, p1, odd, thrp);
#pragma unroll
    for (int r = 0; r < 16; ++r) { p0[r] = __builtin_amdgcn_rcpf(1.0f + __builtin_amdgcn_exp2f(p0[r])); p1[r] = __builtin_amdgcn_rcpf(1.0f + __builtin_amdgcn_exp2f(p1[r])); }
    float s1 = 1.0f, s0 = 1.0f; f32x16 d0v, d1v;
#pragma unroll
    for (int r = 15; r >= 0; --r) { const float n1 = s1 * p1[r]; d1v[r] = s1 - n1; s1 = n1; const float n0 = s0 * p0[r]; d0v[r] = s0 - n0; s0 = n0; }
    const float T1o = swap_other(s1), T0o = swap_other(s0);
    const float c1 = carry * T1o;
    const float off1 = hi ? carry : c1;
    const float c2 = c1 * s1;
    const float off0 = hi ? c2 : c2 * T0o;
    carry = c2 * (s0 * T0o);
#pragma unroll
    for (int j = 0; j < 4; ++j) {
        pw[0][j] = cvtpk(d0v[2 * j] * off0, d0v[2 * j + 1] * off0); pw[1][j] = cvtpk(d0v[8 + 2 * j] * off0, d0v[8 + 2 * j + 1] * off0);
        pw[2][j] = cvtpk(d1v[2 * j] * off1, d1v[2 * j + 1] * off1); pw[3][j] = cvtpk(d1v[8 + 2 * j] * off1, d1v[8 + 2 * j + 1] * off1); }
}
__device__ __forceinline__ void swa_elem(f32x16& p0, f32x16& p1, bool diag, bool low, bool odd, int thrp, float& m_run, float& l_run, f32x16 (&o)[2], u32x4 (&pw)[4]) {
    if (diag) mask_diag<true>(p0, p1, odd, thrp);
    if (low) mask_low(p0, p1, odd, thrp);
    float rm = p0[0];
#pragma unroll
    for (int r = 1; r < 16; ++r) rm = fmaxf(rm, p0[r]);
#pragma unroll
    for (int r = 0; r < 16; ++r) rm = fmaxf(rm, p1[r]);
    rm = fmaxf(rm, swap_other(rm));
    const float mnew = fmaxf(m_run, rm), alpha = __builtin_amdgcn_exp2f(m_run - mnew); m_run = mnew;
    float sum = 0.f;
#pragma unroll
    for (int r = 0; r < 16; ++r) { p0[r] = __builtin_amdgcn_exp2f(p0[r] - mnew); p1[r] = __builtin_amdgcn_exp2f(p1[r] - mnew); sum += p0[r] + p1[r]; }
    l_run = l_run * alpha + sum;
#pragma unroll
    for (int r = 0; r < 16; ++r) { o[0][r] *= alpha; o[1][r] *= alpha; }
#pragma unroll
    for (int j = 0; j < 4; ++j) { pw[0][j] = cvtpk(p0[2 * j], p0[2 * j + 1]); pw[1][j] = cvtpk(p0[8 + 2 * j], p0[8 + 2 * j + 1]); pw[2][j] = cvtpk(p1[2 * j], p1[2 * j + 1]); pw[3][j] = cvtpk(p1[8 + 2 * j], p1[8 + 2 * j + 1]); }
}

template <bool SB> struct UnitDec {
    int b, h, qb;
    __device__ __forceinline__ explicit UnitDec(int n) {
        if (SB) { b = 15 - (n >> 6); h = (n >> 3) & 7; qb = ((n & 7) + (n >> 8)) & 7; }
        else { b = 15 - (n >> 4); h = (n >> 3) & 1; qb = n & 7; }
    }
};
template <bool SB>
__device__ __forceinline__ void attn_run(int n_first, int n_end, int n_stride, const bf16_t* PROJ, bf16_t* Y, const float* __restrict__ sinks, char* shm) {
    if (n_first >= n_end) return;
    const int tid = threadIdx.x, lane = tid & 63, r32 = lane & 31, hi = lane >> 5; const int wid = __builtin_amdgcn_readfirstlane(tid >> 6);
    const unsigned lds0 = (unsigned)(uintptr_t)shm;
    const lds_cptr shm3 = (lds_cptr)shm;
    const int pi = 16 * ((r32 >> 2) & 1) + 4 * (r32 >> 3) + (r32 & 3);
    const int xk = (pi >> 1) & 7;
    const lds_cptr kp0 = shm3 + pi * 128 + ((((hi ^ xk) & 1) | (xk & 6)) << 4);
    const lds_cptr vp0 = shm3 + 8192 + (16 * hi + ((lane & 15) >> 2)) * 64 + ((lane >> 4) & 1) * 32 + (lane & 3) * 8;
    const unsigned stg = lds0 + STG_OFF + wid * 4096;
    const int srow = lane >> 3, spos = lane & 7;
    const int xq = (r32 >> 1) & 7;
    const unsigned stq = stg + r32 * 128 + ((((hi ^ xq) & 1) | (xq & 6)) << 4);
    const unsigned stt = stg + r32 * 128 + (xq << 4) + 8 * hi;
    constexpr int NG = SB ? 1 : 4;
    constexpr int KC0 = SB ? 1792 : 512, VC0 = SB ? 2304 : 640, QC0 = SB ? 1280 : 0, GC0 = SB ? 2816 : 768, YC0 = SB ? 512 : 0;
#define ATT_DMA_WIN(U, TH, TL) do { const int th_ = (TH), tl_ = (TL); \
        const bf16_t* kh_ = PROJ + (long)(U).b * SEQ * PP + KC0 + (U).h * 64; const bf16_t* vh_ = PROJ + (long)(U).b * SEQ * PP + VC0 + (U).h * 64; \
        const bf16_t* ksrc_ = kh_ + (long)(8 * wid + srow) * PP + ((spos ^ ((4 * wid + (srow >> 1)) & 7)) * 8); const bf16_t* vsrc_ = vh_ + (long)(16 * (wid & 3) + (lane >> 2)) * PP + (wid >> 2) * 32 + (lane & 3) * 8; \
        _Pragma("nounroll") for (int rd_ = 0; rd_ < REP_DMA; ++rd_) \
        for (int t_ = th_; t_ >= tl_; --t_) { const unsigned so_ = (unsigned)(th_ - t_) * SLOTB; \
            glds16(ksrc_ + (long)t_ * 64 * PP, (unsigned)__builtin_amdgcn_readfirstlane(lds0 + so_ + wid * 1024)); \
            glds16(vsrc_ + (long)t_ * 64 * PP, (unsigned)__builtin_amdgcn_readfirstlane(lds0 + 8192 + so_ + wid * 1024)); } } while (0)
#define ATT_WIN_LO(TH) (((TH) - (SB ? NSLOT - 1 : 5)) > 0 ? ((TH) - (SB ? NSLOT - 1 : 5)) : 0)
#define ATT_DMA_UNIT(U) ATT_DMA_WIN(U, 4 * (U).qb + 3, ATT_WIN_LO(4 * (U).qb + 3))
#define ATT_QLOAD(dst, U, g) do { const int hq_ = SB ? (U).h : 4 * (U).h + (g); \
        const bf16_t* qp_ = PROJ + ((long)(U).b * SEQ + (U).qb * 256 + wid * 32 + srow) * PP + QC0 + hq_ * 64; \
        _Pragma("unroll") for (int i_ = 0; i_ < 4; ++i_) dst[i_] = *reinterpret_cast<const bf16x8*>(qp_ + (long)(8 * i_) * PP + ((spos ^ ((4 * i_ + (srow >> 1)) & 7)) * 8)); } while (0)
    bf16x8 qn[4];
    { const UnitDec<SB> U0(n_first);
      asm volatile("s_waitcnt lgkmcnt(0)\n\ts_barrier" ::: "memory");
      ATT_DMA_UNIT(U0); ATT_QLOAD(qn, U0, 0); }
#pragma unroll 1
    for (int n = n_first; n < n_end; n += n_stride) {
        const UnitDec<SB> U(n); const bool has_next = (n + n_stride) < n_end; const UnitDec<SB> UN(has_next ? n + n_stride : n);
        const long rowbase = (long)U.b * SEQ; const int Qw = U.qb * 256 + wid * 32;
        const int t_hi = 4 * U.qb + 3;
        const int td = 4 * U.qb + (wid >> 1);
        const int tw_lo = SB ? 0 : ((Qw - 127 > 0 ? Qw - 127 : 0) >> 6);
        asm volatile("s_waitcnt vmcnt(0) lgkmcnt(0)\n\ts_barrier" ::: "memory");
#pragma unroll 1
        for (int gi = 0; gi < NG * REP_CMP; ++gi) {
            const int g = gi % NG; const bool last_g = (gi == NG * REP_CMP - 1);
            const int hq = SB ? U.h : 4 * U.h + g;
            float sink2 = 0.f; if (!SB) sink2 = sinks[__builtin_amdgcn_readfirstlane(hq)] * 1.4426950408889634f;
            bf16x8 qr[4];
#pragma unroll
            for (int i = 0; i < 4; ++i) *(__attribute__((address_space(3))) bf16x8*)(uintptr_t)(stg + i * 1024 + lane * 16) = qn[i];
#pragma unroll
            for (int d0 = 0; d0 < 4; ++d0) qr[d0] = *(const __attribute__((address_space(3))) bf16x8*)(uintptr_t)(stq ^ (unsigned)(d0 << 5));
            asm volatile("s_waitcnt lgkmcnt(0)" ::: "memory");
            { const bf16_t* gsrc = PROJ + (rowbase + Qw + srow) * PP + GC0 + hq * 64;
#pragma unroll
              for (int i = 0; i < 4; ++i) glds16(gsrc + (long)(8 * i) * PP + ((spos ^ ((4 * i + (srow >> 1)) & 7)) * 8), (unsigned)__builtin_amdgcn_readfirstlane(stg + i * 1024)); }
            if (!last_g) ATT_QLOAD(qn, U, (gi + 1) % NG); else if (has_next) ATT_QLOAD(qn, UN, 0);
            f32x16 o[2]; o[0] = f32x16{}; o[1] = f32x16{};
            float inv = 1.0f;
            const bool odd = (wid & 1) != 0; const int thrp = r32 - 16 * hi;
            if constexpr (SB) {
                float carry = 1.0f; bool done = false; int t = td;
                int w_hi = t_hi, w_lo = ATT_WIN_LO(t_hi);
                while (true) {
                    while (t >= w_lo && !done) {
                        const SrcLds S{kp0 + (w_hi - t) * SLOTB, vp0 + (w_hi - t) * SLOTB};
                        bf16x8 kf[8]; load_k(S, kf);
                        f32x16 p0, p1; qk_mma(kf, qr, p0, p1);
                        bf16x8 vf[8]; load_v(S, vf);
                        u32x4 pw[4]; sb_elem(p0, p1, t == td, odd, thrp, hi, carry, pw);
                        pv_mma(vf, pw, o);
                        --t;
                        done = __all(carry < 1.17549435e-38f);
                    }
                    if (lane == 0) *(volatile __attribute__((address_space(3))) unsigned*)(uintptr_t)(lds0 + FLAG_OFF + 4 * wid) = (done || t < 0) ? 1u : 0u;
                    asm volatile("s_waitcnt lgkmcnt(0)\n\ts_barrier" ::: "memory");
                    unsigned allf = 1u;
#pragma unroll
                    for (int w = 0; w < 8; ++w) allf &= *(volatile __attribute__((address_space(3))) unsigned*)(uintptr_t)(lds0 + FLAG_OFF + 4 * w);
                    if (__builtin_amdgcn_readfirstlane(allf)) break;
                    w_hi = w_lo - 1; w_lo = ATT_WIN_LO(w_hi);
                    ATT_DMA_WIN(U, w_hi, w_lo);
                    asm volatile("s_waitcnt vmcnt(0) lgkmcnt(0)\n\ts_barrier" ::: "memory");
                }
            } else {
                float m_run = sink2, l_run = hi ? 0.f : 1.0f;
#pragma unroll 1
                for (int t = td; t >= tw_lo; --t) {
                    const SrcLds S{kp0 + (t_hi - t) * SLOTB, vp0 + (t_hi - t) * SLOTB};
                    bf16x8 kf[8]; load_k(S, kf);
                    f32x16 p0, p1; qk_mma(kf, qr, p0, p1);
                    bf16x8 vf[8]; load_v(S, vf);
                    u32x4 pw[4]; swa_elem(p0, p1, t == td, t == td - 2, odd, thrp, m_run, l_run, o, pw);
                    pv_mma(vf, pw, o);
                }
                const float lt = l_run + swap_other(l_run); inv = 1.0f / lt;
            }
            asm volatile("s_waitcnt vmcnt(0)" ::: "memory");
#pragma unroll
            for (int i = 0; i < 8; ++i) {
                const unsigned a = stt ^ (unsigned)(i << 4);
                const u32x2_t gv = *(const __attribute__((address_space(3))) u32x2_t*)(uintptr_t)a;
                float yv[4];
#pragma unroll
                for (int j = 0; j < 4; ++j) {
                    const unsigned gw = gv[j >> 1]; const float gf = (j & 1) ? __uint_as_float(gw & 0xffff0000u) : __uint_as_float(gw << 16);
                    yv[j] = o[i >> 2][4 * (i & 3) + j] * (inv * gf * __builtin_amdgcn_rcpf(1.0f + __builtin_amdgcn_exp2f(-1.4426950408889634f * gf)));
                }
                *(__attribute__((address_space(3))) u32x2_t*)(uintptr_t)a = (u32x2_t){cvtpk(yv[0], yv[1]), cvtpk(yv[2], yv[3])};
            }
            if (last_g) {
                if (!SB) asm volatile("s_waitcnt lgkmcnt(0)\n\ts_barrier" ::: "memory");
                if (has_next) ATT_DMA_UNIT(UN);
            }
            { bf16_t* yp = Y + (rowbase + Qw + srow) * YP + YC0 + hq * 64;
#pragma unroll
              for (int i = 0; i < 4; ++i) {
                  const u32x4 yv = *(const __attribute__((address_space(3))) u32x4*)(uintptr_t)(stg + i * 1024 + lane * 16);
                  *(u32x4*)(yp + (long)(8 * i) * YP + ((spos ^ ((4 * i + (srow >> 1)) & 7)) * 8)) = yv; } }
            asm volatile("s_waitcnt lgkmcnt(0)" ::: "memory");
        }
    }
#undef ATT_DMA_UNIT
#undef ATT_DMA_WIN
#undef ATT_WIN_LO
#undef ATT_QLOAD
}
}
#define GAS __attribute__((address_space(1)))
#define LAS __attribute__((address_space(3)))
typedef unsigned short bf16;
typedef unsigned v4u __attribute__((ext_vector_type(4)));
typedef float f32x4 __attribute__((ext_vector_type(4)));
typedef short bf16x8 __attribute__((ext_vector_type(8)));
typedef GAS unsigned gu32;
typedef GAS unsigned long long gu64;
#define RLX_AGENT __ATOMIC_RELAXED, __HIP_MEMORY_SCOPE_AGENT
#define LDS_WAIT() asm volatile("s_waitcnt lgkmcnt(0)" ::: "memory")
#define VM_WAIT() asm volatile("s_waitcnt vmcnt(0)" ::: "memory")
__device__ __forceinline__ unsigned long long rt() { return __builtin_amdgcn_s_memrealtime(); }
__device__ __forceinline__ unsigned f2bf(float f) { unsigned u = __builtin_bit_cast(unsigned, f); return (u + 0x7fffu + ((u >> 16) & 1u)) >> 16; }
__device__ __forceinline__ unsigned pk2(float lo, float hi) { return f2bf(lo) | (f2bf(hi) << 16); }

#define XB_TMO      128
#define XB_XCNT(j)  (256  + 64 * (j))
#define XB_XSUB(j)  (1280 + 64 * (j))
#define XB_XGEN(j)  (2304 + 64 * (j))
#define XB_TOP      3328
#define XB_TOPGEN   3392
#define XCD_BAR_WORDS 3456
#define XB_SPIN_CAP (1u << 18)

__device__ __forceinline__ unsigned xb_ld(unsigned* p)              { return __hip_atomic_load(p, __ATOMIC_RELAXED, __HIP_MEMORY_SCOPE_AGENT); }
__device__ __forceinline__ unsigned xb_add(unsigned* p, unsigned v) { return __hip_atomic_fetch_add(p, v, __ATOMIC_RELAXED, __HIP_MEMORY_SCOPE_AGENT); }
__device__ __forceinline__ unsigned xb_xcc_id() { return (unsigned)__builtin_amdgcn_s_getreg((3 << 11) | 20) & 0xFu; }
#define XB_SPIN(cond, bar) do { unsigned _sp = 0; while (cond) { __builtin_amdgcn_s_sleep(1); \
    if ((++_sp & 255u) == 0u) { if (xb_ld(&(bar)[XB_TMO])) break; if (_sp > XB_SPIN_CAP) { atomicAdd(&(bar)[XB_TMO], 1u); break; } } } } while (0)

struct XcdBarrier {
    unsigned* bar; unsigned x;
    volatile LAS unsigned* st;
};

__device__ __forceinline__ XcdBarrier xcd_barrier_post(unsigned* bar, volatile LAS unsigned* st) {
    XcdBarrier b; b.bar = bar; b.x = xb_xcc_id(); b.st = st;
    if (threadIdx.x == 0) (void)xb_add(&bar[XB_XCNT(b.x)], 1u);
    return b;
}
__device__ __forceinline__ void xcd_barrier_complete(unsigned* bar, unsigned x, unsigned& nloc, unsigned& nx) {
    const unsigned G = gridDim.x * gridDim.y * gridDim.z;
    unsigned sum, cnt, mine, sp = 0u;
    for (;;) {
        sum = 0u; cnt = 0u; mine = 0u;
#pragma unroll
        for (unsigned j = 0; j < 16; ++j) { const unsigned c = xb_ld(&bar[XB_XCNT(j)]); sum += c; cnt += (c > 0u) ? 1u : 0u; mine = (j == x) ? c : mine; }
        if (sum == G) break;
        __builtin_amdgcn_s_sleep(1);
        if ((++sp & 255u) == 0u) { if (xb_ld(&bar[XB_TMO])) break; if (sp > XB_SPIN_CAP) { atomicAdd(&bar[XB_TMO], 1u); break; } }
    }
    nloc = mine > 0u ? mine : 1u; nx = cnt > 0u ? cnt : 1u;
}

__device__ __forceinline__ void xcd_barrier(const XcdBarrier& b) {
    asm volatile("s_waitcnt vmcnt(0)" ::: "memory");
    __syncthreads();
    if (threadIdx.x == 0) {
        unsigned* bar = b.bar;
        __builtin_amdgcn_s_waitcnt(0);
        unsigned nloc = b.st[0], nx = b.st[1];
        if (nloc == 0u) { xcd_barrier_complete(bar, b.x, nloc, nx); b.st[0] = nloc; b.st[1] = nx; }
        const unsigned old = xb_add(&bar[XB_XSUB(b.x)], 1u);
        const unsigned gen = old / nloc;
        if (old + 1u == (gen + 1u) * nloc) {
            __builtin_amdgcn_fence(__ATOMIC_RELEASE, "agent");
            asm volatile("s_waitcnt vmcnt(0)" ::: "memory");
            const unsigned og = xb_add(&bar[XB_TOP], 1u);
            const unsigned tg = og / nx;
            if (og + 1u == (tg + 1u) * nx) xb_add(&bar[XB_TOPGEN], 1u);
            else XB_SPIN(xb_ld(&bar[XB_TOPGEN]) == tg, bar);
            __builtin_amdgcn_fence(__ATOMIC_ACQUIRE, "agent");
            xb_add(&bar[XB_XGEN(b.x)], 1u);
            asm volatile("s_waitcnt vmcnt(0)" ::: "memory");
        } else {
            XB_SPIN(xb_ld(&bar[XB_XGEN(b.x)]) == gen, bar);
            __builtin_amdgcn_fence(__ATOMIC_ACQUIRE, "agent");
            asm volatile("s_waitcnt vmcnt(0)" ::: "memory");
        }
    }
    __syncthreads();
}

constexpr int NWAVES = 8;
constexpr int BATCH = 16, SEQ = 2048, D = 1024, M = BATCH * SEQ, NIN = 3328, MIX = 1024;
constexpr float EPS = 1e-6f;
constexpr size_t MiB = 1u << 20;
constexpr size_t WS_CTL = 0, CTL_ZERO_BYTES = 1 * MiB;
constexpr size_t WS_W1T = 2 * MiB;
constexpr size_t WS_W2T = 9 * MiB;
constexpr size_t WS_CS = 12 * MiB;
constexpr size_t WS_XN = 32 * MiB;
constexpr size_t WS_Y = 96 * MiB;
constexpr size_t WS_PROJ = 160 * MiB;
constexpr size_t WS_END = WS_PROJ + (size_t)M * NIN * 2;
constexpr int CW_BAR = 4096;
constexpr int RING_OFF = 0, RING_BYTES = 147456;
constexpr int LDSCTL_OFF = RING_BYTES, MISC_OFF = LDSCTL_OFF + 320;
constexpr int LDS_BYTES = RING_BYTES + 512;
static_assert(att::LDS_BYTES <= RING_BYTES && att::FLAG_OFF == LDSCTL_OFF && LDSCTL_OFF + 64 <= MISC_OFF, "attention LDS");

struct Frame {
    LAS unsigned char* lds;
    volatile LAS unsigned* MISC;
    gu32* ctl;
    int tid, lane, wave;
    int vcu, G;
};

__device__ __forceinline__ float wave_sum(float v) {
#pragma unroll
    for (int o = 1; o < 64; o <<= 1) v += __shfl_xor(v, o);
    return v;
}
__device__ __forceinline__ int phys_row(int L) { const int t = L & 255, wc = t >> 6, bj = (t >> 5) & 1, fq = (t >> 3) & 3, n = (t >> 2) & 1, j = t & 3; return (L & ~255) + 128 * bj + 32 * wc + 16 * n + 4 * fq + j; }
template <bool PERMUTE>
__device__ __forceinline__ void p0_transpose_item(const float* W, int K, int N, bf16* WT, LAS float* scr, int item, int lane) {
    const int nblk = N / 32, kb = item / nblk, nb = item % nblk, k0 = 64 * kb, n0 = 32 * nb;
#pragma unroll 8
    for (int i = 0; i < 32; ++i) { const int kk = 2 * i + (lane >> 5); scr[kk * 33 + (lane & 31)] = W[(size_t)(k0 + kk) * N + n0 + (lane & 31)]; }
    LDS_WAIT(); asm volatile("" ::: "memory");
    const int c = lane & 7;
#pragma unroll
    for (int j = 0; j < 4; ++j) { const int n = (lane >> 3) + 8 * j; const LAS float* s = scr + (8 * c) * 33 + n;
        v4u o; o.x = pk2(s[0 * 33], s[1 * 33]); o.y = pk2(s[2 * 33], s[3 * 33]); o.z = pk2(s[4 * 33], s[5 * 33]); o.w = pk2(s[6 * 33], s[7 * 33]);
        const int row = PERMUTE ? phys_row(n0 + n) : (n0 + n);
        *(GAS v4u*)(WT + (size_t)row * K + k0 + 8 * c) = o; }
    LDS_WAIT(); asm volatile("" ::: "memory");
}
__device__ __forceinline__ void rms_row_to_bf16(int lane, const float* xrow, const float* gain, bf16* orow) {
    const GAS f32x4* xr = (const GAS f32x4*)xrow + lane; const GAS f32x4* gr = (const GAS f32x4*)gain + lane;
    f32x4 v[4]; float s = 0.f;
#pragma unroll
    for (int j = 0; j < 4; ++j) { v[j] = xr[64 * j]; s += (v[j].x * v[j].x + v[j].y * v[j].y) + (v[j].z * v[j].z + v[j].w * v[j].w); }
    const float rstd = 1.f / sqrtf(wave_sum(s) * (1.f / D) + EPS);
    GAS unsigned long long* o8 = (GAS unsigned long long*)orow + lane;
#pragma unroll
    for (int j = 0; j < 4; ++j) { const f32x4 g = gr[64 * j]; const f32x4 y = v[j] * rstd * g;
        o8[64 * j] = (unsigned long long)pk2(y.x, y.y) | ((unsigned long long)pk2(y.z, y.w) << 32); }
}
__device__ __forceinline__ void p0_prologue(Frame& F, const float* x, const int* pos, const float* gain, const float* w_in, const float* w_out, bf16* W1T, bf16* W2T, float* CS, bf16* XN) {
    LAS float* scr = (LAS float*)(F.lds + RING_OFF + F.wave * 16384);
    const int gw = F.vcu * NWAVES + F.wave, NGW = F.G * NWAVES;
    constexpr int I_1 = (D / 64) * (NIN / 32), I_2 = (MIX / 64) * (D / 32);
    for (int it = gw; it < I_1 + I_2; it += NGW) {
        if (it < I_1) p0_transpose_item<true>(w_in, D, NIN, W1T, scr, it, F.lane);
        else p0_transpose_item<false>(w_out, MIX, D, W2T, scr, it - I_1, F.lane);
    }
    for (int e = gw * 64 + F.lane; e < M * 32; e += NGW * 64) {
        const int m = e >> 5, i = e & 31;
        const float inv_freq = exp2f(-(float)i * (13.287712379549449f / 32.0f));
        const float ang = (float)pos[m] * inv_freq;
        double rev = (double)ang * 0.15915494309189535; rev -= __builtin_rint(rev);
        const float rf = (float)rev;
        CS[(size_t)m * 64 + i] = __builtin_amdgcn_cosf(rf); CS[(size_t)m * 64 + 32 + i] = __builtin_amdgcn_sinf(rf);
    }
    for (int m = gw; m < M; m += NGW) rms_row_to_bf16(F.lane, x + (size_t)m * D, gain, XN + (size_t)m * D);
}

#ifndef REP_SWA
#define REP_SWA 1
#endif
#ifndef REP_SB
#define REP_SB 1
#endif
#ifndef REP0
#define REP0 1
#endif
#ifndef REP1
#define REP1 1
#endif
#ifndef REP2
#define REP2 1
#endif
#ifndef REP3
#define REP3 1
#endif
template <int REP> struct RepOrder : pg8::StaticOrder {
    __device__ bool next(int i, pg8::Unit& u) const {
        if (REP == 1) return pg8::StaticOrder::next(i, u);
        const int rc = (nwg - c + G - 1) / G; if (rc <= 0 || i >= REP * rc) return false;
        return pg8::StaticOrder::next(i % rc, u);
    }
};
struct Args { const float* x; const int* pos; const float* gain; const float* w_in; const float* qg; const float* kg; const float* sinks; const float* w_out; float* out; unsigned char* ws; };

__global__ void __launch_bounds__(NWAVES * 64, 2) hyb_fwd(Args args) {
    extern __shared__ __attribute__((aligned(16))) unsigned char lds[];
    Frame F;
    F.lds = (LAS unsigned char*)lds;
    F.MISC = (volatile LAS unsigned*)(F.lds + MISC_OFF);
    F.tid = threadIdx.x; F.lane = F.tid & 63; F.wave = __builtin_amdgcn_readfirstlane(F.tid >> 6);
    F.G = gridDim.x; { const int bx = blockIdx.x; F.vcu = (F.G % 8 == 0) ? (bx % 8) * (F.G / 8) + bx / 8 : bx; }
    unsigned char* ws = args.ws;
    F.ctl = (gu32*)(ws + WS_CTL);
    bf16* W1T = (bf16*)(ws + WS_W1T); bf16* W2T = (bf16*)(ws + WS_W2T); float* CS = (float*)(ws + WS_CS);
    bf16* XN = (bf16*)(ws + WS_XN); bf16* YB = (bf16*)(ws + WS_Y); bf16* PROJ = (bf16*)(ws + WS_PROJ);
    for (int u = F.tid; u < (LDS_BYTES - LDSCTL_OFF) / 4; u += NWAVES * 64) ((LAS unsigned*)(F.lds + LDSCTL_OFF))[u] = 0u;
    __syncthreads();
    XcdBarrier bar = xcd_barrier_post((unsigned*)(F.ctl + CW_BAR), F.MISC + 8);

    _Pragma("nounroll") for (int rep = 0; rep < REP0; ++rep) p0_prologue(F, args.x, args.pos, args.gain, args.w_in, args.w_out, W1T, W2T, CS, XN);
    xcd_barrier(bar);

    {
        pg8::Gemm g{XN, W1T, M, NIN, D}; RepOrder<REP1> S; S.init(M, NIN, F.G, (int)blockIdx.x);
        pg8::EpiProj E{PROJ, NIN, CS, args.qg, args.kg, 0.125f * 1.4426950408889634f};
        pg8::gemm_phase<pg8::EpiProj, RepOrder<REP1>, true, true>(F.lds + RING_OFF, g, S, E);
    }
    xcd_barrier(bar);

    _Pragma("nounroll") for (int rep = 0; rep < REP2; ++rep) {
        char* shm = (char*)lds + RING_OFF;
        _Pragma("nounroll") for (int r2 = 0; r2 < REP_SWA; ++r2)
            att::attn_run<false>(F.vcu, 256, F.G, PROJ, YB, args.sinks, shm);
        _Pragma("nounroll") for (int r2 = 0; r2 < REP_SB; ++r2)
            att::attn_run<true>(F.vcu, 1024, F.G, PROJ, YB, args.sinks, shm);
        asm volatile("s_waitcnt lgkmcnt(0)\n\ts_barrier" ::: "memory");
    }
    xcd_barrier(bar);

    {
        pg8::Gemm g{YB, W2T, M, D, MIX}; RepOrder<REP3> S; S.init(M, D, F.G, (int)blockIdx.x);
        pg8::EpiRes E{args.x, args.out, D};
        pg8::gemm_phase<pg8::EpiRes, RepOrder<REP3>, true, true>(F.lds + RING_OFF, g, S, E);
    }
}

extern "C" void kernel_launch(void* const* d_in, const int* in_sizes, int n_in, void* d_out, int out_size, void* d_ws, size_t ws_size, hipStream_t stream) {
    static int grid = 0;
    if (grid == 0) {
        if (n_in != 8 || in_sizes[0] != M * D || out_size != M * D || ws_size < WS_END) { fprintf(stderr, "kernel_launch: unexpected shapes (n_in %d, in0 %d, out %d, ws %zu < %zu); nothing launched\n", n_in, n_in > 0 ? in_sizes[0] : -1, out_size, ws_size, (size_t)WS_END); grid = -1; return; }
        int dev = 0, cus = 0, per_cu = 0;
        if (hipGetDevice(&dev) != hipSuccess || hipDeviceGetAttribute(&cus, hipDeviceAttributeMultiprocessorCount, dev) != hipSuccess) { grid = -1; return; }
        if (hipFuncSetAttribute((const void*)hyb_fwd, hipFuncAttributeMaxDynamicSharedMemorySize, LDS_BYTES) != hipSuccess) { fprintf(stderr, "kernel_launch: hipFuncSetAttribute failed\n"); grid = -1; return; }
        if (hipOccupancyMaxActiveBlocksPerMultiprocessor(&per_cu, (const void*)hyb_fwd, NWAVES * 64, LDS_BYTES) != hipSuccess || per_cu < 1) { fprintf(stderr, "kernel_launch: occupancy query says %d blocks per CU; nothing launched\n", per_cu); (void)hipGetLastError(); grid = -1; return; }
        grid = cus;
        if (grid % 8 != 0 || grid > 1024) { fprintf(stderr, "kernel_launch: unexpected CU count %d\n", cus); }
    }
    if (grid < 0) return;
    if (hipMemsetAsync((char*)d_ws + WS_CTL, 0, CTL_ZERO_BYTES, stream) != hipSuccess) { fprintf(stderr, "kernel_launch: memset failed\n"); return; }
    Args a{};
    a.x = (const float*)d_in[0]; a.pos = (const int*)d_in[1]; a.gain = (const float*)d_in[2]; a.w_in = (const float*)d_in[3];
    a.qg = (const float*)d_in[4]; a.kg = (const float*)d_in[5]; a.sinks = (const float*)d_in[6]; a.w_out = (const float*)d_in[7];
    a.out = (float*)d_out; a.ws = (unsigned char*)d_ws;
    hipLaunchKernelGGL(hyb_fwd, dim3(grid), dim3(NWAVES * 64), LDS_BYTES, stream, a);
    const hipError_t le = hipPeekAtLastError();
    if (le != hipSuccess) fprintf(stderr, "kernel_launch: launch failed: %s\n", hipGetErrorName(le));
}
```
